# Optimizing an MI355X kernel written in HIP

```python
import math
import jax
import jax.numpy as jnp
from jax import lax
import numpy as np

D_MODEL = 1024
BATCH = 4
SEQ = 8192
DEPTH = 2

GRID_W = 64
CTX_LEN = 256
HEAD_DIM = 64
RWKV_HEADS = 8
RWKV_WIDTH = RWKV_HEADS * HEAD_DIM
LORA_DECAY = 64
LORA_ICLR = 64
LORA_GATE = 160
N_DIRS = 2
SHORT_CONV = 3
DECAY_SCALE = math.exp(-0.5)
GN_EPS = 64e-5
Q_HEADS = 8
KV_HEADS = 2
Q_PER_KV = Q_HEADS // KV_HEADS
ATTN_WIDTH = Q_HEADS * HEAD_DIM
KV_WIDTH = KV_HEADS * HEAD_DIM
ATTN_SCALE = HEAD_DIM ** -0.5
Q_BLOCK = 128
ROPE_BASE = 10000.0
ROPE_PAIRS = HEAD_DIM // 4
N_EXPERTS = 16
EC_CAPACITY = 2
EXPERT_FF = ((8 * D_MODEL // 3 + 127) // 128) * 128
NORM_EPS = 1e-6
RWKV_COLS = 3 * RWKV_WIDTH + LORA_GATE + N_DIRS * (LORA_DECAY + LORA_ICLR)
GQA_COLS = ATTN_WIDTH + 2 * KV_WIDTH
GATE_COLS = 2 * D_MODEL
IN_COLS = RWKV_COLS + GQA_COLS + GATE_COLS

kernel_name = 'hybrid_rwkv7_gqa_ecmoe_dit'


def rms_norm(x, g):
    xf = x.astype(jnp.float32)
    y = xf * lax.rsqrt(jnp.mean(xf * xf, axis=-1, keepdims=True) + NORM_EPS)
    return (y * g.astype(jnp.float32)).astype(x.dtype)


def modulate(x, shift, scale):
    return x * (1 + scale) + shift


def centred_conv(u, w):
    up = jnp.pad(u, ((0, 0), (1, 1), (0, 0)))
    return up[:, :-2] * w[0] + up[:, 1:-1] * w[1] + up[:, 2:] * w[2]


def axial_rope_tables(n_tokens):
    rows = n_tokens // GRID_W
    row = jnp.repeat(jnp.arange(rows, dtype=jnp.float32), GRID_W)
    col = jnp.broadcast_to(jnp.arange(GRID_W, dtype=jnp.float32)[None, :], (rows, GRID_W)).reshape(-1)
    inv = jnp.power(ROPE_BASE, -jnp.arange(ROPE_PAIRS, dtype=jnp.float32) / ROPE_PAIRS)
    ang = jnp.stack([row[:, None] * inv, col[:, None] * inv], axis=1)
    return jnp.cos(ang), jnp.sin(ang)


def apply_axial_rope(x, cos, sin):
    shp = x.shape
    xr = x.reshape(shp[:-1] + (2, 2, ROPE_PAIRS))
    expand = (1, shp[1]) + (1,) * (x.ndim - 3) + (2, ROPE_PAIRS)
    cs = cos.reshape(expand).astype(x.dtype)
    sn = sin.reshape(expand).astype(x.dtype)
    x1, x2 = xr[..., 0, :], xr[..., 1, :]
    out = jnp.stack([x1 * cs - x2 * sn, x2 * cs + x1 * sn], axis=-2)
    return out.reshape(shp)


def wkv_scan(s0, r, decay, kk, ka, k_rep, v, reverse):
    def step(S, inp):
        r_t, w_t, kk_t, ka_t, kr_t, v_t = inp
        removed = jnp.einsum('bhvk,bhk->bhv', S, kk_t)
        S = (S * w_t[:, :, None, :]
             - removed[..., None] * ka_t[:, :, None, :]
             + v_t[..., None] * kr_t[:, :, None, :])
        return S, jnp.einsum('bhvk,bhk->bhv', S, r_t)
    xs = tuple(jnp.swapaxes(t, 0, 1) for t in (r, decay, kk, ka, k_rep, v))
    s_end, y = lax.scan(step, s0, xs, reverse=reverse)
    return s_end, jnp.swapaxes(y, 0, 1)


def rwkv_branch(u, s_init, conv_w, decay_w0, decay_w2, iclr_a0, iclr_a2, gate_g2,
                key_k, key_a, bonus_rho, gn_g, gn_b):
    B, T, _ = u.shape
    dt = u.dtype
    f32 = jnp.float32
    u = centred_conv(u, conv_w)
    W = RWKV_WIDTH
    r, k, v = u[..., :W], u[..., W:2 * W], u[..., 2 * W:3 * W]
    o = 3 * W
    g_lo = u[..., o:o + LORA_GATE]
    o += LORA_GATE
    d_lo = u[..., o:o + N_DIRS * LORA_DECAY].reshape(B, T, N_DIRS, LORA_DECAY)
    o += N_DIRS * LORA_DECAY
    a_lo = u[..., o:o + N_DIRS * LORA_ICLR].reshape(B, T, N_DIRS, LORA_ICLR)
    g = (jax.nn.sigmoid(g_lo) @ gate_g2).astype(f32)
    d = (decay_w0 + jnp.einsum('btzl,zlc->btzc', jnp.tanh(d_lo), decay_w2)).astype(f32)
    decay = jnp.exp(-DECAY_SCALE * jax.nn.sigmoid(d))
    a = jax.nn.sigmoid((iclr_a0 + jnp.einsum('btzl,zlc->btzc', a_lo, iclr_a2)).astype(f32))
    kf = k.astype(f32)
    heads = lambda t: t.reshape(t.shape[:-1] + (RWKV_HEADS, HEAD_DIM))
    kk = heads(kf * key_k)
    kk = kk * lax.rsqrt(jnp.sum(kk * kk, axis=-1, keepdims=True) + 1e-12)
    k_rep = heads(kf[:, :, None, :] * (1 + (a - 1) * key_a))
    decay, a = heads(decay), heads(a)
    rf, vf = heads(r.astype(f32)), heads(v.astype(f32))
    ys, bonuses, ends = [], [], []
    for z in range(N_DIRS):
        s_end, yz = wkv_scan(s_init[z], rf, decay[:, :, z], kk, kk * a[:, :, z],
                             k_rep[:, :, z], vf, reverse=(z == 1))
        ys.append(yz)
        ends.append(s_end)
        bonuses.append(jnp.sum(rf * k_rep[:, :, z] * bonus_rho, axis=-1, keepdims=True))
    y = ys[0] + ys[1]
    mu = jnp.mean(y, axis=-1, keepdims=True)
    var = jnp.mean(jnp.square(y - mu), axis=-1, keepdims=True)
    yn = (y - mu) * lax.rsqrt(var + GN_EPS)
    yn = yn * heads(gn_g.astype(f32)) + heads(gn_b.astype(f32))
    out = (yn + (bonuses[0] + bonuses[1]) * vf).reshape(B, T, W) * g
    return out.astype(dt), jnp.stack(ends, axis=0)


def gqa_project(u, q_norm, k_norm):
    B, T, _ = u.shape
    q = rms_norm(u[..., :ATTN_WIDTH].reshape(B, T, KV_HEADS, Q_PER_KV, HEAD_DIM), q_norm)
    k = rms_norm(u[..., ATTN_WIDTH:ATTN_WIDTH + KV_WIDTH].reshape(B, T, KV_HEADS, HEAD_DIM), k_norm)
    v = u[..., ATTN_WIDTH + KV_WIDTH:].reshape(B, T, KV_HEADS, HEAD_DIM)
    return q, k, v


def latent_attention(q, k, v, kc, vc):
    B, T = q.shape[:2]
    nb = T // Q_BLOCK
    qb = jnp.moveaxis(q.reshape(B, nb, Q_BLOCK, KV_HEADS, Q_PER_KV, HEAD_DIM), 1, 0)

    def block(qi):
        s = jnp.concatenate([jnp.einsum('bqkgd,bskd->bkgqs', qi, k),
                             jnp.einsum('bqkgd,bckd->bkgqc', qi, kc)], axis=-1)
        p = jax.nn.softmax(s.astype(jnp.float32), axis=-1).astype(v.dtype)
        return (jnp.einsum('bkgqs,bskd->bqkgd', p[..., :T], v)
                + jnp.einsum('bkgqc,bckd->bqkgd', p[..., T:], vc))

    o = lax.map(block, qb)
    return jnp.moveaxis(o, 0, 1).reshape(B, T, ATTN_WIDTH)


def context_attention(qc, kc, vc):
    B, L = qc.shape[:2]
    s = jnp.einsum('bqkgd,bckd->bkgqc', qc, kc)
    p = jax.nn.softmax(s.astype(jnp.float32), axis=-1).astype(vc.dtype)
    return jnp.einsum('bkgqc,bckd->bqkgd', p, vc).reshape(B, L, ATTN_WIDTH)


def gated_merge(u_gate, y_rwkv, y_attn, w_branch_rwkv, w_branch_attn, w_out):
    g_rwkv = jax.nn.sigmoid(u_gate[..., :D_MODEL])
    g_attn = jax.nn.sigmoid(u_gate[..., D_MODEL:])
    return (g_rwkv * (y_rwkv @ w_branch_rwkv) + g_attn * (y_attn @ w_branch_attn)) @ w_out


def token_mixer(ul, uc, cos, sin, conv_w, decay_w0, decay_w2, iclr_a0, iclr_a2, gate_g2,
                key_k, key_a, bonus_rho, gn_g, gn_b, q_norm, k_norm,
                w_branch_rwkv, w_branch_attn, w_out, need_ctx):
    r_end, a_end = RWKV_COLS, RWKV_COLS + GQA_COLS
    rw = (conv_w, decay_w0, decay_w2, iclr_a0, iclr_a2, gate_g2, key_k, key_a, bonus_rho, gn_g, gn_b)
    B = ul.shape[0]
    s0 = jnp.zeros((N_DIRS, B, RWKV_HEADS, HEAD_DIM, HEAD_DIM), jnp.float32)
    yc_rwkv, s_ctx = rwkv_branch(uc[..., :r_end], s0, *rw)
    yl_rwkv, _ = rwkv_branch(ul[..., :r_end], s_ctx, *rw)
    ql, kl, vl = gqa_project(ul[..., r_end:a_end], q_norm, k_norm)
    qc, kc, vc = gqa_project(uc[..., r_end:a_end], q_norm, k_norm)
    ql = apply_axial_rope(ql, cos, sin) * ATTN_SCALE
    kl = apply_axial_rope(kl, cos, sin)
    yl_attn = latent_attention(ql, kl, vl, kc, vc)
    yl = gated_merge(ul[..., a_end:], yl_rwkv, yl_attn, w_branch_rwkv, w_branch_attn, w_out)
    if need_ctx:
        yc_attn = context_attention(qc * ATTN_SCALE, kc, vc)
        yc = gated_merge(uc[..., a_end:], yc_rwkv, yc_attn, w_branch_rwkv, w_branch_attn, w_out)
    else:
        yc = None
    return yl, yc


def expert_choice_ffn(h, w_router, w_gate, w_up, w_down):
    B, T, D = h.shape
    cap = EC_CAPACITY * T // N_EXPERTS
    aff = jax.nn.softmax((h @ w_router).astype(jnp.float32), axis=-1)
    gate, idx = lax.top_k(jnp.swapaxes(aff, 1, 2), cap)
    xe = jax.vmap(lambda hb, ib: hb[ib])(h, idx)
    hid = jax.nn.silu(jnp.einsum('becd,edf->becf', xe, w_gate)) * jnp.einsum('becd,edf->becf', xe, w_up)
    ye = jnp.einsum('becf,efd->becd', hid, w_down) * gate[..., None].astype(h.dtype)
    return jax.vmap(lambda yb, ib: jnp.zeros((T, D), yb.dtype).at[ib.reshape(-1)].add(yb.reshape(-1, D)))(ye, idx)


def setup_inputs(seed: int = 0) -> dict:
    key = jax.random.key(seed)
    ks = jax.random.split(key, 32)
    L, D, W, E, F = DEPTH, D_MODEL, RWKV_WIDTH, N_EXPERTS, EXPERT_FF

    def nrm(k, shape, std):
        return std * jax.random.normal(k, shape, jnp.float32)

    conv_base = jnp.array([0.25, 1.0, 0.25], jnp.float32)[None, :, None]
    return {
        'x': nrm(ks[0], (BATCH, SEQ, D), 1.0),
        'c': nrm(ks[1], (BATCH, D), 1.0),
        'ctx': nrm(ks[2], (BATCH, CTX_LEN, D), 1.0),
        'c_ctx': nrm(ks[3], (D,), 1.0),
        'w_mod': nrm(ks[4], (L, D, 6 * D), 0.5 * D ** -0.5),
        'b_mod': nrm(ks[5], (L, 6 * D), 0.02),
        'norm_mix': 1.0 + nrm(ks[6], (L, D), 0.02),
        'norm_ffn': 1.0 + nrm(ks[7], (L, D), 0.02),
        'w_in': nrm(ks[8], (L, D, IN_COLS), D ** -0.5),
        'conv_w': conv_base + nrm(ks[9], (L, SHORT_CONV, RWKV_COLS), 0.05),
        'decay_w0': -1.0 + nrm(ks[10], (L, N_DIRS, W), 0.5),
        'decay_w2': nrm(ks[11], (L, N_DIRS, LORA_DECAY, W), 0.5 * LORA_DECAY ** -0.5),
        'iclr_a0': nrm(ks[12], (L, N_DIRS, W), 0.5),
        'iclr_a2': nrm(ks[13], (L, N_DIRS, LORA_ICLR, W), 0.5 * LORA_ICLR ** -0.5),
        'gate_g2': nrm(ks[14], (L, LORA_GATE, W), LORA_GATE ** -0.5),
        'key_k': 0.85 + nrm(ks[15], (L, W), 0.05),
        'key_a': 1.0 + nrm(ks[16], (L, W), 0.05),
        'bonus_rho': nrm(ks[17], (L, RWKV_HEADS, HEAD_DIM), 0.1),
        'gn_g': 1.0 + nrm(ks[18], (L, W), 0.02),
        'gn_b': nrm(ks[19], (L, W), 0.02),
        'q_norm': 1.0 + nrm(ks[20], (L, HEAD_DIM), 0.02),
        'k_norm': 1.0 + nrm(ks[21], (L, HEAD_DIM), 0.02),
        'w_branch_rwkv': nrm(ks[22], (L, W, D), W ** -0.5),
        'w_branch_attn': nrm(ks[23], (L, ATTN_WIDTH, D), ATTN_WIDTH ** -0.5),
        'w_out': nrm(ks[24], (L, D, D), D ** -0.5),
        'w_router': nrm(ks[25], (L, D, E), D ** -0.5),
        'w_gate': nrm(ks[26], (L, E, D, F), D ** -0.5),
        'w_up': nrm(ks[27], (L, E, D, F), D ** -0.5),
        'w_down': nrm(ks[28], (L, E, F, D), F ** -0.5),
        'norm_final': 1.0 + nrm(ks[29], (D,), 0.02),
    }


def reference(x, c, ctx, c_ctx, w_mod, b_mod, norm_mix, norm_ffn, w_in, conv_w, decay_w0, decay_w2,
              iclr_a0, iclr_a2, gate_g2, key_k, key_a, bonus_rho, gn_g, gn_b, q_norm, k_norm,
              w_branch_rwkv, w_branch_attn, w_out, w_router, w_gate, w_up, w_down, norm_final):
    cos, sin = axial_rope_tables(x.shape[1])
    xl, xc = x, ctx
    for l in range(DEPTH):
        need_ctx = l < DEPTH - 1
        sh1l, sc1l, gt1l, sh2l, sc2l, gt2l = jnp.split((jax.nn.silu(c) @ w_mod[l] + b_mod[l])[:, None, :], 6, axis=-1)
        sh1c, sc1c, gt1c, sh2c, sc2c, gt2c = jnp.split(jax.nn.silu(c_ctx) @ w_mod[l] + b_mod[l], 6, axis=-1)
        hl = modulate(rms_norm(xl, norm_mix[l]), sh1l, sc1l)
        hc = modulate(rms_norm(xc, norm_mix[l]), sh1c, sc1c)
        yl, yc = token_mixer(hl @ w_in[l], hc @ w_in[l], cos, sin, conv_w[l], decay_w0[l], decay_w2[l],
                             iclr_a0[l], iclr_a2[l], gate_g2[l], key_k[l], key_a[l], bonus_rho[l],
                             gn_g[l], gn_b[l], q_norm[l], k_norm[l], w_branch_rwkv[l], w_branch_attn[l],
                             w_out[l], need_ctx)
        xl = xl + gt1l * yl
        hl2 = modulate(rms_norm(xl, norm_ffn[l]), sh2l, sc2l)
        xl = xl + gt2l * expert_choice_ffn(hl2, w_router[l], w_gate[l], w_up[l], w_down[l])
        if need_ctx:
            xc = xc + gt1c * yc
            hc2 = modulate(rms_norm(xc, norm_ffn[l]), sh2c, sc2c)
            xc = xc + gt2c * expert_choice_ffn(hc2, w_router[l], w_gate[l], w_up[l], w_down[l])
    return rms_norm(xl, norm_final)
```

```cpp
#include <hip/hip_runtime.h>
#include <hip/hip_bf16.h>
#include <cstdio>
#include <cstdint>
#include <cmath>

#ifndef MK_PER_PHASE
#define MK_PER_PHASE 0
#endif

__device__ __forceinline__ int ltid() { int t = threadIdx.x; asm volatile("" : "+v"(t)); return t; }
__device__ __forceinline__ int lbid() { int b = blockIdx.x; asm volatile("" : "+s"(b)); return b; }
namespace pg8 {
#define PG8_LAS __attribute__((address_space(3)))
typedef unsigned short bf16_t;
typedef short bf16x8 __attribute__((ext_vector_type(8)));
typedef float f32x4 __attribute__((ext_vector_type(4)));
typedef unsigned u32x4 __attribute__((ext_vector_type(4)));
constexpr int BM = 256, BK = 64, HALF = 128, HTB = HALF * BK * 2  , STAGE_BYTES = 8 * HTB, NXCD = 8, WGM = 8;

__host__ __device__ __forceinline__ int lds_byte(int r, int c) { const int st = (r >> 4) * 2 + (c >> 5), rr = r & 15, cc = c & 31, ob = rr * 64 + cc * 2; return st * 1024 + (ob ^ (((ob >> 9) & 1) << 5)); }
__host__ __device__ __forceinline__ void stage_rc(int b, int& R, int& C) { const int st = b / 1024, sb = b % 1024, swz = sb ^ (((sb >> 9) & 1) << 5); R = (st >> 1) * 16 + swz / 64; C = (st & 1) * 32 + (swz % 64) / 2; }
__host__ __device__ __forceinline__ int perm32(int rho) { const int n = rho >> 4, i = rho & 15; return 8 * (i >> 2) + 4 * n + (i & 3); }

struct Unit { int pm, pn, pb; };
struct Gemm { const bf16_t* A; const bf16_t* Bt; int M, N, K; };

struct StaticOrder {
    int nM, nN, nwg, G, c;
    __host__ __device__ void init(int M, int N, int G_, int c_) { nM = M / BM; nN = N / BM; nwg = nM * nN; G = G_; c = c_; }
    __host__ __device__ bool next(int i, Unit& u) const {
        const long L = (long)i * G + c; if (L >= nwg) return false;
        int wgid = (int)L; { const int q = nwg / NXCD, r = nwg % NXCD, xcd = wgid % NXCD, off = wgid / NXCD; wgid = (xcd < r ? xcd * (q + 1) : r * (q + 1) + (xcd - r) * q) + off; }
        const int nig = WGM * nN, gid = wgid / nig, fm = gid * WGM, gsz = (nM - fm) < WGM ? (nM - fm) : WGM;
        u.pm = fm + ((wgid % nig) % gsz); u.pn = (wgid % nig) / gsz; u.pb = u.pn; return true;
    }
    __device__ __forceinline__ void a_ready(const Unit&) const {}
    __device__ __forceinline__ void done(const Unit&) const {}
};

__device__ __forceinline__ unsigned cvt_pk_bf16(float lo, float hi) { unsigned r; asm volatile("v_cvt_pk_bf16_f32 %0, %1, %2" : "=v"(r) : "v"(lo), "v"(hi)); return r; }
__device__ __forceinline__ float bf_lo(unsigned u) { return __uint_as_float(u << 16); }
__device__ __forceinline__ float bf_hi(unsigned u) { return __uint_as_float(u & 0xffff0000u); }
__device__ __forceinline__ float fsigmoid(float x) { return __builtin_amdgcn_rcpf(1.0f + __expf(-x)); }
__device__ __forceinline__ unsigned pk_f16(float lo, float hi) { const _Float16 a = (_Float16)lo, b = (_Float16)hi; return (unsigned)__builtin_bit_cast(unsigned short, a) | ((unsigned)__builtin_bit_cast(unsigned short, b) << 16); }

struct EpiStore {
    static constexpr bool PERM = true, AFTER_DRAIN = false;
    bf16_t* O; int ldc;
    __device__ __forceinline__ void operator()(const f32x4 (&acc)[2][2][4][2], const Unit& u, int wr, int wc, int fr, int fq) const {
        const int row0 = u.pm * BM + wr * 64 + fr, col0 = u.pn * BM + wc * 32 + 8 * fq;
#pragma unroll
        for (int ai = 0; ai < 2; ++ai)
#pragma unroll
            for (int m = 0; m < 4; ++m) { bf16_t* rowp = O + (size_t)(row0 + ai * HALF + m * 16) * ldc + col0;
#pragma unroll
                for (int bj = 0; bj < 2; ++bj) { const f32x4 v0 = acc[ai][bj][m][0], v1 = acc[ai][bj][m][1];
                    u32x4 w; w.x = cvt_pk_bf16(v0[0], v0[1]); w.y = cvt_pk_bf16(v0[2], v0[3]); w.z = cvt_pk_bf16(v1[0], v1[1]); w.w = cvt_pk_bf16(v1[2], v1[3]);
                    *(u32x4*)(rowp + bj * HALF) = w; } }
    }
};
struct EpiLora {
    static constexpr bool PERM = true, AFTER_DRAIN = false;
    bf16_t* O; int ldc; const float* w0; const float* a0;
    __device__ __forceinline__ void operator()(const f32x4 (&acc)[2][2][4][2], const Unit& u, int wr, int wc, int fr, int fq) const {
        const int row0 = u.pm * BM + wr * 64 + fr, col0 = u.pn * BM + wc * 32 + 8 * fq;
        const int typ = u.pn < 2 ? 0 : (u.pn < 6 ? 1 : 2);
        f32x4 bv[2][2];
#pragma unroll
        for (int bj = 0; bj < 2; ++bj)
#pragma unroll
            for (int n = 0; n < 2; ++n) { const int c = col0 + bj * HALF + 4 * n;
                bv[bj][n] = typ == 0 ? (f32x4){0.f, 0.f, 0.f, 0.f} : (typ == 1 ? *(const f32x4*)(w0 + (c - 512)) : *(const f32x4*)(a0 + (c - 1536))); }
#pragma unroll
        for (int ai = 0; ai < 2; ++ai)
#pragma unroll
            for (int m = 0; m < 4; ++m) { bf16_t* rowp = O + (size_t)(row0 + ai * HALF + m * 16) * ldc + col0;
#pragma unroll
                for (int bj = 0; bj < 2; ++bj) { f32x4 v0 = acc[ai][bj][m][0] + bv[bj][0], v1 = acc[ai][bj][m][1] + bv[bj][1]; u32x4 w;
                    if (typ == 1) {
#pragma unroll
                        for (int i = 0; i < 4; ++i) { v0[i] = __expf(-0.6065306597126334f * fsigmoid(v0[i])); v1[i] = __expf(-0.6065306597126334f * fsigmoid(v1[i])); }
                        w.x = pk_f16(v0[0], v0[1]); w.y = pk_f16(v0[2], v0[3]); w.z = pk_f16(v1[0], v1[1]); w.w = pk_f16(v1[2], v1[3]);
                    } else {
                        if (typ == 2) {
#pragma unroll
                            for (int i = 0; i < 4; ++i) { v0[i] = fsigmoid(v0[i]); v1[i] = fsigmoid(v1[i]); } }
                        w.x = cvt_pk_bf16(v0[0], v0[1]); w.y = cvt_pk_bf16(v0[2], v0[3]); w.z = cvt_pk_bf16(v1[0], v1[1]); w.w = cvt_pk_bf16(v1[2], v1[3]);
                    }
                    *(u32x4*)(rowp + bj * HALF) = w; } }
    }
};
template <int MODE> struct EpiMerge1 {
    static constexpr bool PERM = true, AFTER_DRAIN = false;
    const bf16_t* G; int ldg;
    float* P1; bf16_t* M1;
    __device__ __forceinline__ void operator()(const f32x4 (&acc)[2][2][4][2], const Unit& u, int wr, int wc, int fr, int fq) const {
        const int row0 = u.pm * BM + wr * 64 + fr, col0 = u.pn * BM + wc * 32 + 8 * fq;
#pragma unroll
        for (int ai = 0; ai < 2; ++ai)
#pragma unroll
            for (int m = 0; m < 4; ++m) { const size_t row = (size_t)(row0 + ai * HALF + m * 16);
#pragma unroll
                for (int bj = 0; bj < 2; ++bj) { const int c = col0 + bj * HALF;
                    const u32x4 gw = *(const u32x4*)(G + row * ldg + c);
                    f32x4 g0, g1; g0[0] = fsigmoid(bf_lo(gw.x)); g0[1] = fsigmoid(bf_hi(gw.x)); g0[2] = fsigmoid(bf_lo(gw.y)); g0[3] = fsigmoid(bf_hi(gw.y));
                    g1[0] = fsigmoid(bf_lo(gw.z)); g1[1] = fsigmoid(bf_hi(gw.z)); g1[2] = fsigmoid(bf_lo(gw.w)); g1[3] = fsigmoid(bf_hi(gw.w));
                    f32x4 v0 = acc[ai][bj][m][0] * g0, v1 = acc[ai][bj][m][1] * g1;
                    if (MODE == 0) { *(f32x4*)(P1 + row * 1024 + c) = v0; *(f32x4*)(P1 + row * 1024 + c + 4) = v1; }
                    else { v0 += *(const f32x4*)(P1 + row * 1024 + c); v1 += *(const f32x4*)(P1 + row * 1024 + c + 4);
                        u32x4 w; w.x = cvt_pk_bf16(v0[0], v0[1]); w.y = cvt_pk_bf16(v0[2], v0[3]); w.z = cvt_pk_bf16(v1[0], v1[1]); w.w = cvt_pk_bf16(v1[2], v1[3]);
                        *(u32x4*)(M1 + row * 1024 + c) = w; } } }
    }
};
struct EpiResid {
    static constexpr bool PERM = true, AFTER_DRAIN = false;
    float* X; const float* modl;
    __device__ __forceinline__ void operator()(const f32x4 (&acc)[2][2][4][2], const Unit& u, int wr, int wc, int fr, int fq) const {
        const int row0 = u.pm * BM + wr * 64 + fr, col0 = u.pn * BM + wc * 32 + 8 * fq;
        const int sel = (u.pm % 33 == 0) ? 4 : (u.pm / 33);
        const float* gt = modl + sel * 6144 + 2048;
#pragma unroll
        for (int bj = 0; bj < 2; ++bj) { const int c = col0 + bj * HALF; const f32x4 t0 = *(const f32x4*)(gt + c), t1 = *(const f32x4*)(gt + c + 4);
#pragma unroll
            for (int ai = 0; ai < 2; ++ai)
#pragma unroll
                for (int m = 0; m < 4; ++m) { float* xp = X + (size_t)(row0 + ai * HALF + m * 16) * 1024 + c;
                    const f32x4 x0 = *(const f32x4*)xp, x1 = *(const f32x4*)(xp + 4);
                    *(f32x4*)xp = x0 + t0 * acc[ai][bj][m][0]; *(f32x4*)(xp + 4) = x1 + t1 * acc[ai][bj][m][1]; } }
    }
};
struct EpiMoeUp {
    static constexpr bool PERM = true, AFTER_DRAIN = false;
    bf16_t* HID; int ldc;
    __device__ __forceinline__ void operator()(const f32x4 (&acc)[2][2][4][2], const Unit& u, int wr, int wc, int fr, int fq) const {
        const int row0 = u.pm * BM + wr * 64 + fr, col0 = u.pn * HALF + wc * 32 + 8 * fq;
#pragma unroll
        for (int ai = 0; ai < 2; ++ai)
#pragma unroll
            for (int m = 0; m < 4; ++m) { bf16_t* rowp = HID + (size_t)(row0 + ai * HALF + m * 16) * ldc + col0;
                f32x4 h0, h1;
#pragma unroll
                for (int i = 0; i < 4; ++i) { const float g0 = acc[ai][0][m][0][i], g1 = acc[ai][0][m][1][i];
                    h0[i] = g0 * fsigmoid(g0) * acc[ai][1][m][0][i]; h1[i] = g1 * fsigmoid(g1) * acc[ai][1][m][1][i]; }
                u32x4 w; w.x = cvt_pk_bf16(h0[0], h0[1]); w.y = cvt_pk_bf16(h0[2], h0[3]); w.z = cvt_pk_bf16(h1[0], h1[1]); w.w = cvt_pk_bf16(h1[2], h1[3]);
                *(u32x4*)rowp = w; }
    }
};
struct EpiMoeDown {
    static constexpr bool PERM = true, AFTER_DRAIN = false;
    bf16_t* YE; const float* gatev;
    __device__ __forceinline__ void operator()(const f32x4 (&acc)[2][2][4][2], const Unit& u, int wr, int wc, int fr, int fq) const {
        const int row0 = u.pm * BM + wr * 64 + fr, col0 = u.pn * BM + wc * 32 + 8 * fq;
#pragma unroll
        for (int ai = 0; ai < 2; ++ai)
#pragma unroll
            for (int m = 0; m < 4; ++m) { const size_t row = (size_t)(row0 + ai * HALF + m * 16); const float gv = gatev[row]; bf16_t* rowp = YE + row * 1024 + col0;
#pragma unroll
                for (int bj = 0; bj < 2; ++bj) { const f32x4 v0 = acc[ai][bj][m][0] * gv, v1 = acc[ai][bj][m][1] * gv;
                    u32x4 w; w.x = cvt_pk_bf16(v0[0], v0[1]); w.y = cvt_pk_bf16(v0[2], v0[3]); w.z = cvt_pk_bf16(v1[0], v1[1]); w.w = cvt_pk_bf16(v1[2], v1[3]);
                    *(u32x4*)(rowp + bj * HALF) = w; } }
    }
};
struct MoeOrder {
    int nM, nN, nwg, G, c;
    __host__ __device__ void init(int nM_, int nN_, int G_, int c_) { nM = nM_; nN = nN_; nwg = nM * nN; G = G_; c = c_; }
    __host__ __device__ bool next(int i, Unit& u) const {
        const long L = (long)i * G + c; if (L >= nwg) return false;
        int wgid = (int)L; { const int q = nwg / NXCD, r = nwg % NXCD, xcd = wgid % NXCD, off = wgid / NXCD; wgid = (xcd < r ? xcd * (q + 1) : r * (q + 1) + (xcd - r) * q) + off; }
        const int nig = WGM * nN, gid = wgid / nig, fm = gid * WGM, gsz = (nM - fm) < WGM ? (nM - fm) : WGM;
        u.pm = fm + ((wgid % nig) % gsz); u.pn = (wgid % nig) / gsz;
        const int e = u.pm < 256 ? (u.pm >> 4) : (u.pm - 256); u.pb = e * nN + u.pn; return true;
    }
    __device__ __forceinline__ void a_ready(const Unit&) const {}
    __device__ __forceinline__ void done(const Unit&) const {}
};

template <class Epi, class Sched, bool ALIGN_EPI = false, bool SP2 = false>
__device__ __forceinline__ void gemm_phase(PG8_LAS unsigned char* lds, const Gemm g, const Sched& S, const Epi& E) {
    const int tid = ltid(), wid = __builtin_amdgcn_readfirstlane(tid >> 6), lane = tid & 63, wr = wid >> 2, wc = wid & 3, fr = lane & 15, fq = lane >> 4;
    const int K = g.K, nt = K / BK;
    unsigned voffA[2], voffB[2];
#pragma unroll
    for (int i = 0; i < 2; ++i) { int R, C; stage_rc(tid * 16 + i * 8192, R, C); const int Rb = Epi::PERM ? ((R & ~31) + perm32(R & 31)) : R;
        voffA[i] = (unsigned)(R * K + C) * 2u; voffB[i] = (unsigned)(Rb * K + C) * 2u; }
    const size_t kstep = (size_t)(BK * 2);
    const size_t hstep = (size_t)HALF * K * 2;
    const size_t tstep = 2 * hstep;
    const unsigned ldsw = (unsigned)wid * 1024u;
    const int aoff = lds_byte(wr * 64 + fr, fq * 8), boff = lds_byte(wc * 32 + fr, fq * 8);
#define PG8_SA(b, h) (((b) * 2 + (h)) * HTB)
#define PG8_SB(b, h) ((4 + (b) * 2 + (h)) * HTB)
#define PG8_STAGE(bufoff, gbase, voff) do { _Pragma("unroll") for (int _i = 0; _i < 2; ++_i) \
        __builtin_amdgcn_global_load_lds((const unsigned*)((const char*)(gbase) + (voff)[_i]), (PG8_LAS unsigned*)(lds + (bufoff) + ldsw + _i * 8192), 16, 0, 0); } while (0)
#define PG8_LDA(dst, b, h) do { _Pragma("unroll") for (int m = 0; m < 4; ++m) _Pragma("unroll") for (int k = 0; k < 2; ++k) dst[m][k] = *(const PG8_LAS bf16x8*)(lds + PG8_SA(b, h) + aoff + m * 2048 + k * 1024); } while (0)
#define PG8_LDB(dst, b, h) do { _Pragma("unroll") for (int n = 0; n < 2; ++n) _Pragma("unroll") for (int k = 0; k < 2; ++k) dst[n][k] = *(const PG8_LAS bf16x8*)(lds + PG8_SB(b, h) + boff + n * 2048 + k * 1024); } while (0)
#define PG8_MMA(ai, bj, At, Bt) do { __builtin_amdgcn_s_setprio(1); _Pragma("unroll") for (int m = 0; m < 4; ++m) _Pragma("unroll") for (int n = 0; n < 2; ++n) _Pragma("unroll") for (int k = 0; k < 2; ++k) \
        acc[ai][bj][m][n] = __builtin_amdgcn_mfma_f32_16x16x32_bf16(Bt[n][k], At[m][k], acc[ai][bj][m][n], 0, 0, 0); __builtin_amdgcn_s_setprio(0); } while (0)
#define PG8_WAIT_V(n) asm volatile("s_waitcnt vmcnt(" #n ")" ::: "memory")
#define PG8_WAIT_L(n) asm volatile("s_waitcnt lgkmcnt(" #n ")" ::: "memory")
#define PG8_BAR __builtin_amdgcn_s_barrier()
#define PG8_SCHED __builtin_amdgcn_sched_barrier(0)
    Unit cur, nxt; int ui = 0;
    if (!S.next(0, cur)) return;
    f32x4 acc[2][2][4][2];
#pragma unroll
    for (int a = 0; a < 2; ++a)
#pragma unroll
        for (int b = 0; b < 2; ++b)
#pragma unroll
            for (int m = 0; m < 4; ++m)
#pragma unroll
                for (int n = 0; n < 2; ++n) acc[a][b][m][n] = (f32x4){0.f, 0.f, 0.f, 0.f};
    bf16x8 At[4][2], B0[2][2], B1[2][2];
    const char* cA = (const char*)g.A + (size_t)cur.pm * tstep; const char* cB = (const char*)g.Bt + (size_t)cur.pb * tstep;
    S.a_ready(cur);
    if constexpr (SP2) {
        PG8_STAGE(PG8_SB(0, 0), cB, voffB); PG8_STAGE(PG8_SB(0, 1), cB + hstep, voffB); PG8_STAGE(PG8_SA(0, 0), cA, voffA); PG8_STAGE(PG8_SA(0, 1), cA + hstep, voffA);
        if (wr == 1) PG8_BAR;
        PG8_WAIT_V(2); PG8_BAR;
        PG8_STAGE(PG8_SB(1, 0), cB + kstep, voffB); PG8_STAGE(PG8_SA(1, 0), cA + kstep, voffA); PG8_STAGE(PG8_SB(1, 1), cB + hstep + kstep, voffB);
        PG8_WAIT_V(6); PG8_BAR;
    } else {
        PG8_STAGE(PG8_SB(0, 0), cB, voffB); PG8_STAGE(PG8_SA(0, 0), cA, voffA); PG8_STAGE(PG8_SB(0, 1), cB + hstep, voffB); PG8_STAGE(PG8_SA(0, 1), cA + hstep, voffA);
        if (wr == 1) PG8_BAR;
        PG8_WAIT_V(4); PG8_BAR;
        PG8_STAGE(PG8_SB(1, 0), cB + kstep, voffB); PG8_STAGE(PG8_SA(1, 0), cA + kstep, voffA); PG8_STAGE(PG8_SB(1, 1), cB + hstep + kstep, voffB);
        PG8_WAIT_V(6); PG8_BAR;
    }
    for (;;) {
        const bool has_next = S.next(ui + 1, nxt);
        const char* nA = has_next ? (const char*)g.A + (size_t)nxt.pm * tstep : cA; const char* nB = has_next ? (const char*)g.Bt + (size_t)nxt.pb * tstep : cB;
        for (int t = 0; t < nt; t += 2) {
            const bool last = (t == nt - 2);
            const char* a1 = cA + (size_t)(t + 1) * kstep;
            const char* a2 = last ? nA : cA + (size_t)(t + 2) * kstep; const char* b2 = last ? nB : cB + (size_t)(t + 2) * kstep;
            const char* a3 = a2 + kstep; const char* b3 = b2 + kstep;
            if (last && has_next) S.a_ready(nxt);
            if constexpr (SP2) {
            PG8_LDB(B0, 0, 0); PG8_LDB(B1, 0, 1); PG8_SCHED; PG8_LDA(At, 0, 0); PG8_STAGE(PG8_SA(1, 1), a1 + hstep, voffA);
            PG8_WAIT_V(8); PG8_WAIT_L(0); PG8_BAR; PG8_MMA(0, 0, At, B0); PG8_MMA(0, 1, At, B1); PG8_BAR; PG8_SCHED;
            PG8_LDA(At, 0, 1); PG8_STAGE(PG8_SB(0, 0), b2, voffB); PG8_STAGE(PG8_SB(0, 1), b2 + hstep, voffB); PG8_STAGE(PG8_SA(0, 0), a2, voffA);
            PG8_WAIT_V(8); PG8_WAIT_L(0); PG8_BAR; PG8_MMA(1, 0, At, B0); PG8_MMA(1, 1, At, B1); PG8_BAR; PG8_SCHED;
            PG8_LDB(B0, 1, 0); PG8_LDB(B1, 1, 1); PG8_SCHED; PG8_LDA(At, 1, 0); PG8_STAGE(PG8_SA(0, 1), a2 + hstep, voffA);
            PG8_WAIT_V(8); PG8_WAIT_L(0); PG8_BAR; PG8_MMA(0, 0, At, B0); PG8_MMA(0, 1, At, B1); PG8_BAR; PG8_SCHED;
            PG8_LDA(At, 1, 1); PG8_STAGE(PG8_SB(1, 0), b3, voffB); PG8_STAGE(PG8_SB(1, 1), b3 + hstep, voffB); PG8_STAGE(PG8_SA(1, 0), a3, voffA);
            PG8_WAIT_V(8); PG8_WAIT_L(0); PG8_BAR; PG8_MMA(1, 0, At, B0); PG8_MMA(1, 1, At, B1); PG8_BAR; PG8_SCHED;
            } else {
            PG8_LDB(B0, 0, 0); PG8_SCHED; PG8_LDA(At, 0, 0); PG8_STAGE(PG8_SA(1, 1), a1 + hstep, voffA);
            PG8_WAIT_L(8); PG8_BAR; PG8_WAIT_L(0); PG8_MMA(0, 0, At, B0); PG8_BAR; PG8_SCHED;
            PG8_LDB(B1, 0, 1); PG8_STAGE(PG8_SB(0, 0), b2, voffB);
            PG8_BAR; PG8_WAIT_L(0); PG8_MMA(0, 1, At, B1); PG8_BAR;
            PG8_LDA(At, 0, 1); PG8_STAGE(PG8_SA(0, 0), a2, voffA);
            PG8_BAR; PG8_WAIT_L(0); PG8_MMA(1, 0, At, B0); PG8_BAR; PG8_SCHED;
            PG8_STAGE(PG8_SB(0, 1), b2 + hstep, voffB);
            PG8_WAIT_V(6); PG8_BAR; PG8_MMA(1, 1, At, B1); PG8_BAR;
            PG8_LDB(B0, 1, 0); PG8_SCHED; PG8_LDA(At, 1, 0); PG8_STAGE(PG8_SA(0, 1), a2 + hstep, voffA);
            PG8_WAIT_L(8); PG8_BAR; PG8_WAIT_L(0); PG8_MMA(0, 0, At, B0); PG8_BAR; PG8_SCHED;
            PG8_LDB(B1, 1, 1); PG8_STAGE(PG8_SB(1, 0), b3, voffB);
            PG8_BAR; PG8_WAIT_L(0); PG8_MMA(0, 1, At, B1); PG8_BAR;
            PG8_LDA(At, 1, 1); PG8_STAGE(PG8_SA(1, 0), a3, voffA);
            PG8_BAR; PG8_WAIT_L(0); PG8_MMA(1, 0, At, B0); PG8_BAR; PG8_SCHED;
            PG8_STAGE(PG8_SB(1, 1), b3 + hstep, voffB);
            PG8_WAIT_V(6); PG8_BAR; PG8_MMA(1, 1, At, B1); PG8_BAR;
            }
        }
        if constexpr (ALIGN_EPI) { if (wr == 0) PG8_BAR; }
        if constexpr (!Epi::AFTER_DRAIN) { E(acc, cur, wr, wc, fr, fq); S.done(cur); }
        if (!has_next) break;
#pragma unroll
        for (int a = 0; a < 2; ++a)
#pragma unroll
            for (int b = 0; b < 2; ++b)
#pragma unroll
                for (int m = 0; m < 4; ++m)
#pragma unroll
                    for (int n = 0; n < 2; ++n) acc[a][b][m][n] = (f32x4){0.f, 0.f, 0.f, 0.f};
        cur = nxt; cA = nA; cB = nB; ++ui;
        if constexpr (ALIGN_EPI) { if (wr == 1) PG8_BAR; }
    }
    PG8_WAIT_V(0);
    if constexpr (!ALIGN_EPI) { if (wr == 0) PG8_BAR; }
    PG8_BAR;
    if constexpr (Epi::AFTER_DRAIN) { E.fused(acc, cur, wr, wc, fr, fq, lds, wid, lane); S.done(cur); }
#undef PG8_SA
#undef PG8_SB
#undef PG8_STAGE
#undef PG8_LDA
#undef PG8_LDB
#undef PG8_MMA
#undef PG8_WAIT_V
#undef PG8_WAIT_L
#undef PG8_BAR
#undef PG8_SCHED
}
}

namespace attn_body {
using bf16=__hip_bfloat16;
using bf16x8=__attribute__((ext_vector_type(8)))short;
using s16x4=__attribute__((ext_vector_type(4)))short;
using f32x16=__attribute__((ext_vector_type(16)))float;
using u32x4=__attribute__((ext_vector_type(4)))unsigned;
constexpr int D=64,QP=512,KP=128;
constexpr int NW=8,QBLK=32,QB=QBLK*NW,KVBLK=64;
constexpr int ATTN_UNIT_ROWS=QB;
__device__ __forceinline__ int crow(int r,int hi){return (r&3)+8*(r>>2)+4*hi;}
#define SBAR() __builtin_amdgcn_sched_barrier(0)
constexpr int NSLOT=3, SLOTB=8192;
constexpr int LDS_K=0, LDS_V=NSLOT*SLOTB, LDS_WS=2*NSLOT*SLOTB, LDS_OST=LDS_WS+NW*64*4, LDS_BYTES=LDS_OST+NW*4096;
constexpr float C2=0.125f*1.4426950408889634f;
__device__ __forceinline__ void glds16(const void*gsrc,unsigned lds_dst){unsigned keep;
  asm volatile("s_mov_b32 %0, m0\n\ts_mov_b32 m0, %2\n\ts_nop 0\n\tglobal_load_lds_dwordx4 %1, off\n\ts_mov_b32 m0, %0":"=&s"(keep):"v"(gsrc),"s"(lds_dst):"memory");}
__device__ __forceinline__ float max3f(float a,float b,float c){float r;asm("v_max3_f32 %0, %1, %2, %3":"=v"(r):"v"(a),"v"(b),"v"(c));return r;}
__device__ __forceinline__ float max2f(float a,float b){float r;asm("v_max_f32_e32 %0, %1, %2":"=v"(r):"v"(a),"v"(b));return r;}
__device__ __forceinline__ float fadd_s(float a,float b){float r;asm("v_add_f32_e32 %0, %1, %2":"=v"(r):"v"(a),"v"(b));return r;}
__device__ __forceinline__ float fsub_s(float a,float b){float r;asm("v_sub_f32_e32 %0, %1, %2":"=v"(r):"v"(a),"v"(b));return r;}
typedef float f32x2_t __attribute__((ext_vector_type(2))); typedef __bf16 bf16x2_t __attribute__((ext_vector_type(2)));
__device__ __forceinline__ unsigned cvtpk_s(float lo,float hi){f32x2_t v={lo,hi};bf16x2_t b=__builtin_convertvector(v,bf16x2_t);return __builtin_bit_cast(unsigned,b);}
#define WAIT_BAR(N) asm volatile("s_waitcnt vmcnt(" #N ") lgkmcnt(0)\n\ts_barrier":::"memory")

__device__ __forceinline__ void qkt(f32x16&p0,f32x16&p1,const char*Kslot,const bf16x8*qr,const f32x16&negm,int r32,int hi){
  const char*kb=Kslot+hi*1024+r32*16;
  #pragma unroll
  for(int d0=0;d0<4;++d0){
    const bf16x8 b0=*reinterpret_cast<const bf16x8*>(kb+d0*2048);
    const bf16x8 b1=*reinterpret_cast<const bf16x8*>(kb+d0*2048+512);
    if(d0==0){p0=__builtin_amdgcn_mfma_f32_32x32x16_bf16(b0,qr[0],negm,0,0,0);p1=__builtin_amdgcn_mfma_f32_32x32x16_bf16(b1,qr[0],negm,0,0,0);}
    else{p0=__builtin_amdgcn_mfma_f32_32x32x16_bf16(b0,qr[d0],p0,0,0,0);p1=__builtin_amdgcn_mfma_f32_32x32x16_bf16(b1,qr[d0],p1,0,0,0);}}
}
typedef __attribute__((address_space(3))) const char* lds_cptr;
typedef short v4i16_t __attribute__((ext_vector_type(4)));
__device__ __forceinline__ void kload8(bf16x8*kf,lds_cptr kp){
  kf[0]=*(const __attribute__((address_space(3))) bf16x8*)(kp);      kf[1]=*(const __attribute__((address_space(3))) bf16x8*)(kp+512);
  kf[2]=*(const __attribute__((address_space(3))) bf16x8*)(kp+2048); kf[3]=*(const __attribute__((address_space(3))) bf16x8*)(kp+2560);
  kf[4]=*(const __attribute__((address_space(3))) bf16x8*)(kp+4096); kf[5]=*(const __attribute__((address_space(3))) bf16x8*)(kp+4608);
  kf[6]=*(const __attribute__((address_space(3))) bf16x8*)(kp+6144); kf[7]=*(const __attribute__((address_space(3))) bf16x8*)(kp+6656);
}
__device__ __forceinline__ void kload2(bf16x8*kf,lds_cptr kp,int j){ kf[2*j]=*(const __attribute__((address_space(3))) bf16x8*)(kp+j*2048); kf[2*j+1]=*(const __attribute__((address_space(3))) bf16x8*)(kp+j*2048+512); }
__device__ __forceinline__ s16x4 vtr(lds_cptr p){ return __builtin_bit_cast(s16x4,__builtin_amdgcn_ds_read_tr16_b64_v4i16((__attribute__((address_space(3))) v4i16_t*)p)); }
__device__ __forceinline__ float rowmax(const f32x16&p0,const f32x16&p1){
  float a=max3f(p0[0],p0[1],p1[0]),b=max3f(p0[2],p0[3],p1[1]);a=max3f(a,p1[2],p1[3]);
  #pragma unroll
  for(int r=4;r<16;r+=4){a=max3f(a,p0[r],p0[r+1]);b=max3f(b,p0[r+2],p0[r+3]);a=max3f(a,p1[r],p1[r+1]);b=max3f(b,p1[r+2],p1[r+3]);}
  const float m=max2f(a,b);
  auto rr=__builtin_amdgcn_permlane32_swap(__float_as_uint(m),__float_as_uint(m),false,false);
  return max2f(__uint_as_float(rr[0]),__uint_as_float(rr[1]));
}
__device__ __forceinline__ void pv(f32x16*o,int vb,bf16x8 pa0,bf16x8 pa1,bf16x8 pa2,bf16x8 pa3){
  #pragma unroll
  for(int d0=0;d0<2;++d0){s16x4 lo[4],hi[4];
    #pragma unroll
    for(int ks=0;ks<4;++ks){
      asm volatile("ds_read_b64_tr_b16 %0,%1 offset:%c2":"=&v"(lo[ks]):"v"(vb),"i"(d0*4096+ks*1024):"memory");
      asm volatile("ds_read_b64_tr_b16 %0,%1 offset:%c2":"=&v"(hi[ks]):"v"(vb),"i"(d0*4096+ks*1024+512):"memory");}
    asm volatile("s_waitcnt lgkmcnt(0)":::"memory");SBAR();
    #define PK(k) (bf16x8){lo[k][0],lo[k][1],lo[k][2],lo[k][3],hi[k][0],hi[k][1],hi[k][2],hi[k][3]}
    o[d0]=__builtin_amdgcn_mfma_f32_32x32x16_bf16(pa0,PK(0),o[d0],0,0,0);
    o[d0]=__builtin_amdgcn_mfma_f32_32x32x16_bf16(pa1,PK(1),o[d0],0,0,0);
    o[d0]=__builtin_amdgcn_mfma_f32_32x32x16_bf16(pa2,PK(2),o[d0],0,0,0);
    o[d0]=__builtin_amdgcn_mfma_f32_32x32x16_bf16(pa3,PK(3),o[d0],0,0,0);
    #undef PK
  }
}

#ifndef ATTN_STORE16
#define ATTN_STORE16(p,v) (*(u32x4*)(p)=(v))
#endif
template<int THRL> __device__ __forceinline__ void attn_unit(long qrow0,int h,long krow0,int NT,const bf16*Q,const bf16*__restrict__ K,const bf16*__restrict__ V,bf16*O,char*shm){
  const int tid=ltid(),lane=tid&63,r32=lane&31,hi=lane>>5; const int wid=__builtin_amdgcn_readfirstlane(tid>>6);
  const bf16*Qw=Q+(qrow0+wid*QBLK)*QP+h*D;
  const bf16*Kh=K+krow0*KP+(h>>2)*D,*Vh=V+krow0*KP+(h>>2)*D;
  const unsigned lds0=(unsigned)(uintptr_t)shm;
  float*wsf=(float*)(shm+LDS_WS)+wid*64;
  const bf16*ksrc=Kh+(long)lane*KP+wid*8;
  const bf16*vsrc=Vh+(long)(16*(wid&3)+(lane>>2))*KP+(wid>>2)*32+(lane&3)*8;
  const unsigned kdst=lds0+LDS_K+wid*1024, vdst=lds0+LDS_V+wid*1024;
  #define DMA_K(t,slot) glds16(ksrc+(long)(t)*KVBLK*KP,(unsigned)__builtin_amdgcn_readfirstlane(kdst+(slot)))
  #define DMA_V(t,slot) glds16(vsrc+(long)(t)*KVBLK*KP,(unsigned)__builtin_amdgcn_readfirstlane(vdst+(slot)))
  const int vb0=(int)(lds0+LDS_V)+((lane>>4)&1)*32+(lane&3)*8+(4*hi+((lane&15)>>2))*64;
  const char*Kbase=shm+LDS_K; bf16x8 kf[8];
  const lds_cptr shm3=(lds_cptr)shm; const lds_cptr kp0=shm3+LDS_K+hi*1024+r32*16; const lds_cptr vp0=shm3+LDS_V+((lane>>4)&1)*32+(lane&3)*8+(4*hi+((lane&15)>>2))*64;
  DMA_K(0,0);DMA_V(0,0);DMA_K(1,SLOTB);
  bf16x8 qr[4];
  #pragma unroll
  for(int d0=0;d0<4;++d0)qr[d0]=*reinterpret_cast<const bf16x8*>(&Qw[(long)r32*QP+d0*16+hi*8]);
  float mhat=0.f,l_reg=0.f;f32x16 o[2];o[0]=f32x16{};o[1]=f32x16{};f32x16 negm=f32x16{};asm volatile("":"+v"(negm));
  #define CMASK(P0,P1,t) do{}while(0)
  bool resc=false;
  #define START(P0,P1) do{ const float rm=rowmax(P0,P1); resc=false; \
    { const float dl=rm; mhat=fadd_s(mhat,dl); \
      _Pragma("unroll") for(int r=0;r<16;++r){P0[r]=fsub_s(P0[r],dl);P1[r]=fsub_s(P1[r],dl);} \
      _Pragma("unroll") for(int r=0;r<16;++r)negm[r]=-mhat; asm volatile("":"+v"(negm)); } \
    _Pragma("unroll") for(int r=0;r<16;++r)P0[r]=__builtin_amdgcn_exp2f(P0[r]); }while(0)
  #define RESC() do{ if(resc){ asm volatile("s_waitcnt lgkmcnt(0)":::"memory"); \
      _Pragma("unroll") for(int d_=0;d_<2;++d_) _Pragma("unroll") for(int r=0;r<16;++r)o[d_][r]*=wsf[crow(r,hi)]; } }while(0)
  f32x16 pA0,pA1,pB0,pB1;
  int sl_prev=0,sl_cur=0,sl_next=SLOTB;
  #define ROT() do{sl_prev=sl_cur;sl_cur=sl_next;sl_next=(sl_next==(NSLOT-1)*SLOTB)?0:sl_next+SLOTB;}while(0)
  DMA_K(2,2*SLOTB);
  WAIT_BAR(3);
  qkt(pA0,pA1,Kbase,qr,negm,r32,hi);asm volatile("s_nop 15\n\ts_nop 7":"+v"(pA0),"+v"(pA1));CMASK(pA0,pA1,0);
  START(pA0,pA1);
  _Pragma("unroll") for(int r=0;r<16;++r)pA1[r]=__builtin_amdgcn_exp2f(pA1[r]);
  WAIT_BAR(0);
  DMA_K(3,0);DMA_V(1,SLOTB);
  ROT();
  kload8(kf,kp0+sl_cur);
  WAIT_BAR(2);
  s16x4 vlo[8],vhi[8]; u32x4 pw0,pw1,pw2,pw3;
  #define PKW(P,B) cvtpk_s(P[B],P[B+1])
  #define PAF(k) __builtin_bit_cast(bf16x8,pw##k)
  #define VFR(i) (bf16x8){vlo[i][0],vlo[i][1],vlo[i][2],vlo[i][3],vhi[i][0],vhi[i][1],vhi[i][2],vhi[i][3]}
  #define PIN(x) asm volatile("":"+v"(x))
  #define MX3(a,b,c) __builtin_fmaxf(__builtin_fmaxf((a),(b)),(c))
  #define GAPA(MF,A0,A1,A2,A3,W0,W1,PW) do{ MF; sacc+=A0; sacc+=A1; sacc+=A2; sacc+=A3; PIN(sacc); W0; W1; PIN(PW); SBAR(); }while(0)
  #define EX(v) __builtin_amdgcn_exp2f(v)
  #define GAPB(MF,X,B) do{ MF; X[B]=EX(X[B]); X[B+1]=EX(X[B+1]); X[B+2]=EX(X[B+2]); X[B+3]=EX(X[B+3]); PIN(X); SBAR(); }while(0)
  #define VRD(i) do{ vlo[i]=vtr(vp_+(((i)>>2)*4096+((i)&3)*1024)); vhi[i]=vtr(vp_+(((i)>>2)*4096+((i)&3)*1024+512)); }while(0)
  #define KRD(G,j) do{ if(G){ kload2(kf,kp0+sl_next,j); SBAR(); } }while(0)
  #define STEP(C0,C1,P0,P1,t,GK,GV,GL) do{ SBAR(); \
    const lds_cptr vp_=vp0+sl_prev; \
    VRD(0); SBAR(); float sacc=(P0[0]+P0[1]); \
    GAPA(C0=__builtin_amdgcn_mfma_f32_32x32x16_bf16(kf[0],qr[0],negm,0,0,0), P0[2],P0[3],P0[4],P0[5],     pw0[0]=PKW(P0,0), pw0[1]=PKW(P0,2), pw0); \
    VRD(4); SBAR(); GAPA(C1=__builtin_amdgcn_mfma_f32_32x32x16_bf16(kf[1],qr[0],negm,0,0,0), P0[6],P0[7],P0[8],P0[9],     pw0[2]=PKW(P0,4), pw0[3]=PKW(P0,6), pw0); \
    VRD(1); SBAR(); GAPA(C0=__builtin_amdgcn_mfma_f32_32x32x16_bf16(kf[2],qr[1],C0,0,0,0),   P0[10],P0[11],P0[12],P0[13], pw1[0]=PKW(P0,8), pw1[1]=PKW(P0,10), pw1); \
    VRD(5); SBAR(); GAPA(C1=__builtin_amdgcn_mfma_f32_32x32x16_bf16(kf[3],qr[1],C1,0,0,0),   P0[14],P0[15],P1[0],P1[1],   pw1[2]=PKW(P0,12),pw1[3]=PKW(P0,14), pw1); \
    VRD(2); SBAR(); GAPA(C0=__builtin_amdgcn_mfma_f32_32x32x16_bf16(kf[4],qr[2],C0,0,0,0),   P1[2],P1[3],P1[4],P1[5],     pw2[0]=PKW(P1,0), pw2[1]=PKW(P1,2), pw2); \
    VRD(6); SBAR(); GAPA(C1=__builtin_amdgcn_mfma_f32_32x32x16_bf16(kf[5],qr[2],C1,0,0,0),   P1[6],P1[7],P1[8],P1[9],     pw2[2]=PKW(P1,4), pw2[3]=PKW(P1,6), pw2); \
    VRD(3); SBAR(); GAPA(C0=__builtin_amdgcn_mfma_f32_32x32x16_bf16(kf[6],qr[3],C0,0,0,0),   P1[10],P1[11],P1[12],P1[13], pw3[0]=PKW(P1,8), pw3[1]=PKW(P1,10), pw3); \
    VRD(7); SBAR(); GAPA(C1=__builtin_amdgcn_mfma_f32_32x32x16_bf16(kf[7],qr[3],C1,0,0,0),   P1[14],P1[15],0.f,0.f,       pw3[2]=PKW(P1,12),pw3[3]=PKW(P1,14), pw3); \
    l_reg+=sacc; \
    if(GK){DMA_K((t)+3,sl_cur);} if(GV){DMA_V((t)+1,sl_next);} \
    CMASK(C0,C1,t); \
    { float a=MX3(C0[0],C0[1],C1[0]),b=MX3(C0[2],C0[3],C1[1]); a=MX3(a,C1[2],C1[3]); \
      _Pragma("unroll") for(int r=4;r<16;r+=4){a=MX3(a,C0[r],C0[r+1]);b=MX3(b,C0[r+2],C0[r+3]);a=MX3(a,C1[r],C1[r+1]);b=MX3(b,C1[r+2],C1[r+3]);} \
      float rm=__builtin_fmaxf(a,b); { auto rr=__builtin_amdgcn_permlane32_swap(__float_as_uint(rm),__float_as_uint(rm),false,false); rm=__builtin_fmaxf(__uint_as_float(rr[0]),__uint_as_float(rr[1])); } \
      resc=false; \
      if(__builtin_expect(__any(rm>(float)THRL),0)){ const float dl=__builtin_fmaxf(rm,0.f); mhat+=dl; \
        _Pragma("unroll") for(int r=0;r<16;++r){C0[r]-=dl;C1[r]-=dl;} \
        _Pragma("unroll") for(int r=0;r<16;++r)negm[r]=-mhat; asm volatile("":"+v"(negm)); \
        const float f=__builtin_amdgcn_exp2f(-dl); l_reg*=f; if(hi==0)wsf[r32]=f; resc=true; } } \
    SBAR(); \
    GAPB(o[0]=__builtin_amdgcn_mfma_f32_32x32x16_bf16(PAF(0),VFR(0),o[0],0,0,0), C0,0); \
    GAPB(o[1]=__builtin_amdgcn_mfma_f32_32x32x16_bf16(PAF(0),VFR(4),o[1],0,0,0), C0,4); \
    KRD(GL,0); GAPB(o[0]=__builtin_amdgcn_mfma_f32_32x32x16_bf16(PAF(1),VFR(1),o[0],0,0,0), C0,8); \
    KRD(GL,1); GAPB(o[1]=__builtin_amdgcn_mfma_f32_32x32x16_bf16(PAF(1),VFR(5),o[1],0,0,0), C0,12); \
    KRD(GL,2); GAPB(o[0]=__builtin_amdgcn_mfma_f32_32x32x16_bf16(PAF(2),VFR(2),o[0],0,0,0), C1,0); \
    KRD(GL,3); GAPB(o[1]=__builtin_amdgcn_mfma_f32_32x32x16_bf16(PAF(2),VFR(6),o[1],0,0,0), C1,4); \
    GAPB(o[0]=__builtin_amdgcn_mfma_f32_32x32x16_bf16(PAF(3),VFR(3),o[0],0,0,0), C1,8); \
    GAPB(o[1]=__builtin_amdgcn_mfma_f32_32x32x16_bf16(PAF(3),VFR(7),o[1],0,0,0), C1,12); \
    }while(0)
  int t=1;
  #undef CMASK
  #define CMASK(P0,P1,t) do{}while(0)
  for(;t+5<NT;t+=2){
    STEP(pB0,pB1,pA0,pA1,t,true,true,true);     WAIT_BAR(2); RESC(); ROT();
    STEP(pA0,pA1,pB0,pB1,t+1,true,true,true);   WAIT_BAR(2); RESC(); ROT();
  }
  #undef CMASK
  #define CMASK(P0,P1,t) do{}while(0)
  #define ENDW(tt) do{ if((tt)+3<NT){WAIT_BAR(2);} else if((tt)+2<NT){WAIT_BAR(1);} else {WAIT_BAR(0);} }while(0)
  for(;t+1<NT;t+=2){
    STEP(pB0,pB1,pA0,pA1,t,(t+3<NT),(t+1<NT),(t+1<NT));       ENDW(t);   RESC(); ROT();
    STEP(pA0,pA1,pB0,pB1,t+1,(t+4<NT),(t+2<NT),(t+2<NT));     ENDW(t+1); RESC(); ROT();
  }
  STEP(pB0,pB1,pA0,pA1,NT-1,false,false,false); RESC();
  { float sacc=pB0[0]+pB0[1]; _Pragma("unroll") for(int r=2;r<16;++r)sacc+=pB0[r]; _Pragma("unroll") for(int r=0;r<16;++r)sacc+=pB1[r]; l_reg+=sacc;
    pw0=(u32x4){PKW(pB0,0),PKW(pB0,2),PKW(pB0,4),PKW(pB0,6)};pw1=(u32x4){PKW(pB0,8),PKW(pB0,10),PKW(pB0,12),PKW(pB0,14)};pw2=(u32x4){PKW(pB1,0),PKW(pB1,2),PKW(pB1,4),PKW(pB1,6)};pw3=(u32x4){PKW(pB1,8),PKW(pB1,10),PKW(pB1,12),PKW(pB1,14)};
    SBAR(); pv(o,vb0+sl_cur,PAF(0),PAF(1),PAF(2),PAF(3)); }
  #undef PKW
  #undef PAF
  #undef VFR
  #undef PIN
  #undef MX3
  #undef GAPA
  #undef GAPB
  #undef EX
  #undef VRD
  #undef KRD
  #undef STEP
  #undef ENDW
  {auto rr=__builtin_amdgcn_permlane32_swap(__float_as_uint(l_reg),__float_as_uint(l_reg),false,false);l_reg=__uint_as_float(rr[0])+__uint_as_float(rr[1]);}
  if(hi==0)wsf[32+r32]=l_reg;asm volatile("s_waitcnt lgkmcnt(0)":::"memory");
  float rli[16];
  #pragma unroll
  for(int r=0;r<16;++r)rli[r]=__builtin_amdgcn_rcpf(wsf[32+crow(r,hi)]);
  bf16*Ow=O+(qrow0+wid*QBLK)*QP+h*D;
  { bf16*stg=(bf16*)(shm+LDS_OST)+wid*2048;
    #pragma unroll
    for(int r=0;r<16;++r){const int orow=crow(r,hi);
      #pragma unroll
      for(int d0=0;d0<2;++d0)stg[orow*64+d0*32+r32]=__float2bfloat16(o[d0][r]*rli[r]);}
    asm volatile("s_waitcnt lgkmcnt(0)":::"memory");
    #pragma unroll
    for(int i=0;i<4;++i){const int row=i*8+(lane>>3),ch=lane&7; const u32x4 v=*(const u32x4*)(stg+row*64+ch*8); ATTN_STORE16(Ow+(long)row*QP+ch*8,v);} }
  asm volatile("s_waitcnt lgkmcnt(0)\n\ts_barrier":::"memory");
  #undef DMA_K
  #undef DMA_V
  #undef CMASK
  #undef START
  #undef RESC
  #undef ROT
}
constexpr int ATTN_LDS_BYTES=LDS_BYTES;
#undef SBAR
#undef WAIT_BAR
}

constexpr int NWAVES = 8;
constexpr int NB = 4, TL = 8192, TCX = 256, TP = TL + TCX  , MR = NB * TP  , DM = 1024, NLAYER = 2;
constexpr int RW = 512, NE = 16, FF = 2816;
constexpr int UC = 4864;
constexpr int U_R = 0, U_K = 512, U_V = 1024, U_GLO = 1536, U_DLO = 1696, U_ALO = 1824, RWKV_COLS = 1952, U_Q = 1952, U_KQ = 2464, U_VQ = 2592, U_GR = 2720, U_GA = 3744, IN_COLS = 4768;
constexpr int LOC = 2560;
constexpr int CAP_L = 1024, CAP_C = 32;
constexpr int SLOT_L = NE * NB * CAP_L  , SLOT_ALL = SLOT_L + NE * 256  ;
constexpr float NORM_EPS = 1e-6f, GN_EPS = 64e-5f;
constexpr float QSCALE = 0.125f * 1.4426950408889634f;

constexpr size_t al256(size_t x) { return (x + 255) & ~(size_t)255; }
constexpr size_t WS_CTL = 0, CTL_ZERO_BYTES = 1u << 20;
constexpr size_t WS_MODV = CTL_ZERO_BYTES;
constexpr size_t WS_ROPE = WS_MODV + al256((size_t)2 * 5 * 6144 * 4);
constexpr size_t WS_WIN = WS_ROPE + (size_t)TL * 32 * 8;
constexpr size_t WS_WLORA = WS_WIN + (size_t)2 * UC * DM * 2;
constexpr size_t WS_WBR = WS_WLORA + (size_t)2 * LOC * 512 * 2;
constexpr size_t WS_WBA = WS_WBR + (size_t)2 * DM * 512 * 2;
constexpr size_t WS_WOUT = WS_WBA + (size_t)2 * DM * 512 * 2;
constexpr size_t WS_WGU = WS_WOUT + (size_t)2 * DM * DM * 2;
constexpr size_t WS_WD = WS_WGU + (size_t)NE * 2 * FF * DM * 2;
constexpr size_t WS_X = WS_WD + (size_t)NE * DM * FF * 2;
constexpr size_t WS_H = WS_X + (size_t)MR * DM * 4;
constexpr size_t WS_AFF = WS_H + (size_t)MR * DM * 2;
constexpr size_t WS_TOKMAP = WS_AFF + (size_t)MR * 16 * 4;
constexpr size_t WS_IDX = WS_TOKMAP + (size_t)MR * 16 * 4;
constexpr size_t WS_GATEV = WS_IDX + al256((size_t)SLOT_ALL * 4);
constexpr size_t WS_BIG = WS_GATEV + al256((size_t)SLOT_ALL * 4);
constexpr size_t WS_U = WS_BIG;
constexpr size_t WS_RKV = WS_U + (size_t)MR * UC * 2;
constexpr size_t WS_L = WS_RKV + (size_t)MR * 1536 * 2;
constexpr size_t WS_LO = WS_L + (size_t)MR * 512 * 2;
constexpr size_t WS_Q = WS_LO + (size_t)MR * LOC * 2;
constexpr size_t WS_KB = WS_Q + (size_t)MR * 512 * 2;
constexpr size_t WS_VB = WS_KB + (size_t)MR * 128 * 2;
constexpr size_t WS_Y = WS_VB + (size_t)MR * 128 * 2;
constexpr size_t WS_YR = WS_Y + (size_t)2 * MR * 512 * 4;
constexpr size_t WS_MIX_END = WS_YR + (size_t)MR * 512 * 2;
constexpr size_t WS_P1 = WS_RKV;
constexpr size_t WS_M1 = WS_P1 + (size_t)MR * DM * 4;
static_assert(WS_M1 + (size_t)MR * DM * 2 <= WS_Q, "P1/M1 overlay");
constexpr size_t WS_XE = WS_BIG;
constexpr size_t WS_HID = WS_XE + (size_t)SLOT_ALL * DM * 2;
constexpr size_t WS_MOE_END = WS_HID + (size_t)SLOT_ALL * FF * 2;
constexpr size_t WS_END = WS_MIX_END > WS_MOE_END ? WS_MIX_END : WS_MOE_END;
constexpr int CW_TMO = 0, CW_CODE = 1, CW_BAR = 4096;

constexpr int RING_OFF = 0, RING_BYTES = 131072;
constexpr int LDSCTL_OFF = RING_BYTES, MISC_OFF = LDSCTL_OFF + 320;
constexpr int LDS_BYTES = 147456;

#define GAS __attribute__((address_space(1)))
#define LAS __attribute__((address_space(3)))
typedef unsigned short bf16;
typedef unsigned v4u __attribute__((ext_vector_type(4)));
typedef unsigned v2u __attribute__((ext_vector_type(2)));
typedef float f32x4 __attribute__((ext_vector_type(4)));
typedef GAS unsigned gu32;
#define RLX_AGENT __ATOMIC_RELAXED, __HIP_MEMORY_SCOPE_AGENT
#define LDS_WAIT() asm volatile("s_waitcnt lgkmcnt(0)" ::: "memory")
#define VM_WAIT() asm volatile("s_waitcnt vmcnt(0)" ::: "memory")
__device__ __forceinline__ unsigned f2bf(float f) { unsigned u = __builtin_bit_cast(unsigned, f); return (u + 0x7fffu + ((u >> 16) & 1u)) >> 16; }
__device__ __forceinline__ unsigned pk2(float lo, float hi) { return f2bf(lo) | (f2bf(hi) << 16); }
__device__ __forceinline__ float bflo(unsigned u) { return __uint_as_float(u << 16); }
__device__ __forceinline__ float bfhi(unsigned u) { return __uint_as_float(u & 0xffff0000u); }
__device__ __forceinline__ float bf1(bf16 u) { return __uint_as_float((unsigned)u << 16); }
__device__ __forceinline__ float sigm(float x) { return 1.0f / (1.0f + __expf(-x)); }

#define XB_TMO      128
#define XB_XCNT(j)  (256  + 64 * (j))
#define XB_XSUB(j)  (1280 + 64 * (j))
#define XB_XGEN(j)  (2304 + 64 * (j))
#define XB_TOP      3328
#define XB_TOPGEN   3392
#define XCD_BAR_WORDS 3456
#define XB_SPIN_CAP (1u << 18)

__device__ __forceinline__ unsigned xb_ld(unsigned* p)              { return __hip_atomic_load(p, __ATOMIC_RELAXED, __HIP_MEMORY_SCOPE_AGENT); }
__device__ __forceinline__ unsigned xb_add(unsigned* p, unsigned v) { return __hip_atomic_fetch_add(p, v, __ATOMIC_RELAXED, __HIP_MEMORY_SCOPE_AGENT); }
__device__ __forceinline__ unsigned xb_xcc_id() { return (unsigned)__builtin_amdgcn_s_getreg((3 << 11) | 20) & 0xFu; }
#define XB_SPIN(cond, bar) do { unsigned _sp = 0; while (cond) { __builtin_amdgcn_s_sleep(1); \
    if ((++_sp & 255u) == 0u) { if (xb_ld(&(bar)[XB_TMO])) break; if (_sp > XB_SPIN_CAP) { atomicAdd(&(bar)[XB_TMO], 1u); break; } } } } while (0)

struct XcdBarrier {
    unsigned* bar; unsigned x;
    volatile LAS unsigned* st;
};

__device__ __forceinline__ XcdBarrier xcd_barrier_post(unsigned* bar, volatile LAS unsigned* st) {
    XcdBarrier b; b.bar = bar; b.x = xb_xcc_id(); b.st = st;
    if (threadIdx.x == 0) (void)xb_add(&bar[XB_XCNT(b.x)], 1u);
    return b;
}
__device__ __forceinline__ void xcd_barrier_complete(unsigned* bar, unsigned x, unsigned& nloc, unsigned& nx) {
    const unsigned G = gridDim.x * gridDim.y * gridDim.z;
    unsigned sum, cnt, mine, sp = 0u;
    for (;;) {
        sum = 0u; cnt = 0u; mine = 0u;
#pragma unroll
        for (unsigned j = 0; j < 16; ++j) { const unsigned c = xb_ld(&bar[XB_XCNT(j)]); sum += c; cnt += (c > 0u) ? 1u : 0u; mine = (j == x) ? c : mine; }
        if (sum == G) break;
        __builtin_amdgcn_s_sleep(1);
        if ((++sp & 255u) == 0u) { if (xb_ld(&bar[XB_TMO])) break; if (sp > XB_SPIN_CAP) { atomicAdd(&bar[XB_TMO], 1u); break; } }
    }
    nloc = mine > 0u ? mine : 1u; nx = cnt > 0u ? cnt : 1u;
}

__device__ __forceinline__ void xcd_barrier(const XcdBarrier& b) {
    asm volatile("s_waitcnt vmcnt(0)" ::: "memory");
    __syncthreads();
    if (threadIdx.x == 0) {
        unsigned* bar = b.bar;
        __builtin_amdgcn_s_waitcnt(0);
        unsigned nloc = b.st[0], nx = b.st[1];
        if (nloc == 0u) { xcd_barrier_complete(bar, b.x, nloc, nx); b.st[0] = nloc; b.st[1] = nx; }
        const unsigned old = xb_add(&bar[XB_XSUB(b.x)], 1u);
        const unsigned gen = old / nloc;
        if (old + 1u == (gen + 1u) * nloc) {
            __builtin_amdgcn_fence(__ATOMIC_RELEASE, "agent");
            asm volatile("s_waitcnt vmcnt(0)" ::: "memory");
            const unsigned og = xb_add(&bar[XB_TOP], 1u);
            const unsigned tg = og / nx;
            if (og + 1u == (tg + 1u) * nx) xb_add(&bar[XB_TOPGEN], 1u);
            else XB_SPIN(xb_ld(&bar[XB_TOPGEN]) == tg, bar);
            __builtin_amdgcn_fence(__ATOMIC_ACQUIRE, "agent");
            xb_add(&bar[XB_XGEN(b.x)], 1u);
            asm volatile("s_waitcnt vmcnt(0)" ::: "memory");
        } else {
            XB_SPIN(xb_ld(&bar[XB_XGEN(b.x)]) == gen, bar);
            __builtin_amdgcn_fence(__ATOMIC_ACQUIRE, "agent");
            asm volatile("s_waitcnt vmcnt(0)" ::: "memory");
        }
    }
    __syncthreads();
}

struct Args { const float* in[30]; float* out; unsigned char* ws; int ph_lo, ph_hi, use_bar, pad; };
struct Frame {
    LAS unsigned char* lds;
    int tid, lane, wave, vcu, G;
    unsigned char* ws;
};
typedef const __attribute__((address_space(4))) Args* KA;
__device__ __forceinline__ KA kargs() { KA p = (KA)__builtin_amdgcn_kernarg_segment_ptr(); asm volatile("" : "+s"(p)); return p; }
__device__ __forceinline__ Frame mk_frame(KA A) {
    Frame F; F.lds = (LAS unsigned char*)0; F.tid = ltid(); F.lane = F.tid & 63; F.wave = __builtin_amdgcn_readfirstlane(F.tid >> 6);
    F.G = gridDim.x; { const int bx = lbid(); F.vcu = (F.G % 8 == 0) ? (bx % 8) * (F.G / 8) + bx / 8 : bx; }
    F.ws = A->ws; return F;
}
enum { I_X = 0, I_C, I_CTX, I_CCTX, I_WMOD, I_BMOD, I_NMIX, I_NFFN, I_WIN, I_CONVW, I_DW0, I_DW2, I_A0, I_A2, I_G2, I_KEYK, I_KEYA, I_RHO, I_GNG, I_GNB, I_QN, I_KN, I_WBR, I_WBA, I_WOUT, I_WROUTER, I_WGATE, I_WUP, I_WDOWN, I_NFINAL };

__device__ __forceinline__ float wave_sum(float v) {
#pragma unroll
    for (int o = 1; o < 64; o <<= 1) v += __shfl_xor(v, o);
    return v;
}
__device__ __forceinline__ float sum8(float v) { v += __shfl_xor(v, 1); v += __shfl_xor(v, 2); v += __shfl_xor(v, 4); return v; }

__device__ __forceinline__ void transpose_item(const float* W, int K, int N, int k0, int n0, bf16* dst, LAS float* scr, int lane) {
#pragma unroll 8
    for (int i = 0; i < 32; ++i) { const int kk = 2 * i + (lane >> 5); scr[kk * 33 + (lane & 31)] = W[(size_t)(k0 + kk) * N + n0 + (lane & 31)]; }
    LDS_WAIT(); asm volatile("" ::: "memory");
    const int c = lane & 7;
#pragma unroll
    for (int j = 0; j < 4; ++j) { const int n = (lane >> 3) + 8 * j; const LAS float* s = scr + (8 * c) * 33 + n;
        v4u o; o.x = pk2(s[0 * 33], s[1 * 33]); o.y = pk2(s[2 * 33], s[3 * 33]); o.z = pk2(s[4 * 33], s[5 * 33]); o.w = pk2(s[6 * 33], s[7 * 33]);
        *(GAS v4u*)(dst + (size_t)n * K + k0 + 8 * c) = o; }
    LDS_WAIT(); asm volatile("" ::: "memory");
}
__device__ __forceinline__ void transpose_matrix(const Frame& F, const float* W, int K, int N, bf16* WT, LAS float* scr, int& itbase) {
    const int gw = F.vcu * NWAVES + F.wave, NGW = F.G * NWAVES;
    const int nblk = N / 32, nit = (K / 64) * nblk;
    int it = ((gw - itbase) % NGW + NGW) % NGW;
    for (; it < nit; it += NGW) { const int kb = it / nblk, nb = it % nblk; transpose_item(W, K, N, 64 * kb, 32 * nb, WT + (size_t)(32 * nb) * K, scr, F.lane); }
    itbase = (itbase + nit) % NGW;
}
__device__ __forceinline__ void cvt_moe(const Frame& F, KA A, int l) {
    LAS float* scr = (LAS float*)(F.lds + RING_OFF + F.wave * 16384);
    const int gw = F.vcu * NWAVES + F.wave, NGW = F.G * NWAVES;
    bf16* Wgu = (bf16*)(F.ws + WS_WGU); bf16* Wd = (bf16*)(F.ws + WS_WD);
    constexpr int IT_G = 16 * 88, IT_D = 44 * 32, PER_E = 2 * IT_G + IT_D;
    for (int it = gw; it < NE * PER_E; it += NGW) {
        const int e = it / PER_E; int r = it % PER_E;
        if (r < 2 * IT_G) { const int up = r >= IT_G; if (up) r -= IT_G; const int kb = r / 88, nb = r % 88, n0 = 32 * nb;
            const float* W = (up ? A->in[I_WUP] : A->in[I_WGATE]) + ((size_t)l * NE + e) * DM * FF;
            transpose_item(W, DM, FF, 64 * kb, n0, Wgu + ((size_t)e * 2 * FF + 256 * (n0 >> 7) + (n0 & 127) + (up ? 128 : 0)) * DM, scr, F.lane);
        } else { r -= 2 * IT_G; const int kb = r / 32, nb = r % 32;
            const float* W = A->in[I_WDOWN] + ((size_t)l * NE + e) * FF * DM;
            transpose_item(W, FF, DM, 64 * kb, 32 * nb, Wd + ((size_t)e * DM + 32 * nb) * FF, scr, F.lane); }
    }
}
__device__ __forceinline__ void p_prologue() {
    KA A = kargs(); const Frame F = mk_frame(A);
    const int gw = F.vcu * NWAVES + F.wave, NGW = F.G * NWAVES;
    const int gt = (F.vcu * NWAVES * 64) + F.tid, NGT = F.G * NWAVES * 64;
    {
        LAS float* SC = (LAS float*)(F.lds);
        LAS float* PS = (LAS float*)(F.lds + 32768);
        if ((int)blockIdx.x < 192) {
            for (int i = F.tid; i < 5 * 1024; i += NWAVES * 64) { const int v = i >> 10, k = i & 1023; const float cv = v < 4 ? A->in[I_C][v * 1024 + k] : A->in[I_CCTX][k]; SC[i] = cv / (1.0f + expf(-cv)); }
            __syncthreads();
            for (int it = blockIdx.x; it < 192; it += F.G) {
                const int l = it / 96, col = (it % 96) * 64 + F.lane;
                const float* W = A->in[I_WMOD] + (size_t)l * DM * 6144 + col;
                float a0 = 0.f, a1 = 0.f, a2 = 0.f, a3 = 0.f, a4 = 0.f;
                const int kb = F.wave * 128;
#pragma unroll 4
                for (int k = 0; k < 128; ++k) { const float w = W[(size_t)(kb + k) * 6144];
                    a0 += SC[kb + k] * w; a1 += SC[1024 + kb + k] * w; a2 += SC[2048 + kb + k] * w; a3 += SC[3072 + kb + k] * w; a4 += SC[4096 + kb + k] * w; }
                PS[(F.wave * 5 + 0) * 64 + F.lane] = a0; PS[(F.wave * 5 + 1) * 64 + F.lane] = a1; PS[(F.wave * 5 + 2) * 64 + F.lane] = a2; PS[(F.wave * 5 + 3) * 64 + F.lane] = a3; PS[(F.wave * 5 + 4) * 64 + F.lane] = a4;
                __syncthreads();
                if (F.tid < 320) { const int v = F.tid >> 6, cl = F.tid & 63; float s = 0.f;
#pragma unroll
                    for (int w = 0; w < 8; ++w) s += PS[(w * 5 + v) * 64 + cl];
                    const int c2 = (it % 96) * 64 + cl;
                    ((float*)(F.ws + WS_MODV))[((size_t)l * 5 + v) * 6144 + c2] = s + A->in[I_BMOD][l * 6144 + c2]; }
                __syncthreads();
            }
        }
        __syncthreads();
    }
    for (int i = gt; i < TL * 32; i += NGT) { const int t = i >> 5, e = i & 31, ax = e >> 4, pr = e & 15;
        const float pos = (float)(ax == 0 ? (t >> 6) : (t & 63)); const float inv = powf(10000.0f, -(float)pr / 16.0f); const float ang = pos * inv;
        ((float2*)(F.ws + WS_ROPE))[i] = make_float2(cosf(ang), sinf(ang)); }
    for (int i = gt; i < 2 * LOC * 512; i += NGT) { const int l = i / (LOC * 512), r = i % (LOC * 512), n = r >> 9, k = r & 511; float v = 0.f;
        if (n < 512) { if (k < 160) v = A->in[I_G2][((size_t)l * 160 + k) * 512 + n]; }
        else if (n < 1536) { const int z = (n - 512) >> 9, c = (n - 512) & 511, k0 = 160 + 64 * z; if (k >= k0 && k < k0 + 64) v = A->in[I_DW2][(((size_t)l * 2 + z) * 64 + (k - k0)) * 512 + c]; }
        else { const int z = (n - 1536) >> 9, c = (n - 1536) & 511, k0 = 288 + 64 * z; if (k >= k0 && k < k0 + 64) v = A->in[I_A2][(((size_t)l * 2 + z) * 64 + (k - k0)) * 512 + c]; }
        ((bf16*)(F.ws + WS_WLORA))[i] = (bf16)f2bf(v); }
    for (int i = gt; i < 2 * (UC - IN_COLS) * DM / 8; i += NGT) { const int l = i / ((UC - IN_COLS) * DM / 8), r = i % ((UC - IN_COLS) * DM / 8);
        ((GAS v4u*)(F.ws + WS_WIN + ((size_t)l * UC + IN_COLS) * DM * 2))[r] = (v4u){0u, 0u, 0u, 0u}; }
    LAS float* scr = (LAS float*)(F.lds + RING_OFF + F.wave * 16384);
    int itbase = 0;
#pragma unroll 1
    for (int l = 0; l < NLAYER; ++l) {
        transpose_matrix(F, A->in[I_WIN] + (size_t)l * DM * IN_COLS, DM, IN_COLS, (bf16*)(F.ws + WS_WIN) + (size_t)l * UC * DM, scr, itbase);
        transpose_matrix(F, A->in[I_WBR] + (size_t)l * 512 * DM, 512, DM, (bf16*)(F.ws + WS_WBR) + (size_t)l * DM * 512, scr, itbase);
        transpose_matrix(F, A->in[I_WBA] + (size_t)l * 512 * DM, 512, DM, (bf16*)(F.ws + WS_WBA) + (size_t)l * DM * 512, scr, itbase);
        transpose_matrix(F, A->in[I_WOUT] + (size_t)l * DM * DM, DM, DM, (bf16*)(F.ws + WS_WOUT) + (size_t)l * DM * DM, scr, itbase);
    }
    cvt_moe(F, A, 0);
}

template <int MODE> __device__ __forceinline__ void p_rownorm() {
    KA A = kargs(); const Frame F = mk_frame(A);
    const int gw = F.vcu * NWAVES + F.wave, NGW = F.G * NWAVES;
    constexpr int l = MODE == 0 ? 0 : 1, lprev = MODE == 2 ? 1 : 0;
    float* X = (float*)(F.ws + WS_X); bf16* H = (bf16*)(F.ws + WS_H);
    const float* modv = (const float*)(F.ws + WS_MODV);
    const int* TOKMAP = (const int*)(F.ws + WS_TOKMAP); const bf16* YE = (const bf16*)(F.ws + WS_XE);
    for (int row = gw; row < MR; row += NGW) {
        const int b = row / TP, p = row % TP, sel = p < TCX ? 4 : b;
        if (MODE == 2 && p < TCX) continue;
        const float* src = MODE == 0 ? (p < TCX ? A->in[I_CTX] + ((size_t)b * TCX + p) * DM : A->in[I_X] + ((size_t)b * TL + (p - TCX)) * DM) : X + (size_t)row * DM;
        f32x4 v[4];
#pragma unroll
        for (int j = 0; j < 4; ++j) v[j] = *(const GAS f32x4*)(src + 4 * F.lane + 256 * j);
        if (MODE >= 1) {
            const int tm = TOKMAP[(size_t)row * 16 + (F.lane & 15)];
            f32x4 acc[4];
#pragma unroll
            for (int j = 0; j < 4; ++j) acc[j] = (f32x4){0.f, 0.f, 0.f, 0.f};
#pragma unroll
            for (int e = 0; e < 16; ++e) { const int sr = __builtin_amdgcn_readlane(tm, e);
                if (sr >= 0) { const bf16* yr = YE + (size_t)sr * DM + 4 * F.lane;
#pragma unroll
                    for (int j = 0; j < 4; ++j) { const v2u w = *(const GAS v2u*)(yr + 256 * j); acc[j][0] += bflo(w.x); acc[j][1] += bfhi(w.x); acc[j][2] += bflo(w.y); acc[j][3] += bfhi(w.y); } } }
            const float* g2 = modv + ((size_t)lprev * 5 + sel) * 6144 + 5 * 1024 + 4 * F.lane;
#pragma unroll
            for (int j = 0; j < 4; ++j) v[j] += *(const f32x4*)(g2 + 256 * j) * acc[j];
        }
        float ss = 0.f;
#pragma unroll
        for (int j = 0; j < 4; ++j) ss += (v[j][0] * v[j][0] + v[j][1] * v[j][1]) + (v[j][2] * v[j][2] + v[j][3] * v[j][3]);
        const float rinv = 1.0f / sqrtf(wave_sum(ss) * (1.0f / DM) + NORM_EPS);
        if (MODE == 2) {
            float* o = A->out + ((size_t)b * TL + (p - TCX)) * DM + 4 * F.lane; const float* nf = A->in[I_NFINAL] + 4 * F.lane;
#pragma unroll
            for (int j = 0; j < 4; ++j) *(GAS f32x4*)(o + 256 * j) = v[j] * rinv * *(const f32x4*)(nf + 256 * j);
        } else {
            const float* nw = A->in[I_NMIX] + l * DM + 4 * F.lane; const float* sh = modv + ((size_t)l * 5 + sel) * 6144 + 4 * F.lane; const float* sc = sh + 1024;
            bf16* ho = H + (size_t)row * DM + 4 * F.lane; float* xo = X + (size_t)row * DM + 4 * F.lane;
#pragma unroll
            for (int j = 0; j < 4; ++j) { *(GAS f32x4*)(xo + 256 * j) = v[j];
                const f32x4 hh = v[j] * rinv * *(const f32x4*)(nw + 256 * j) * (1.0f + *(const f32x4*)(sc + 256 * j)) + *(const f32x4*)(sh + 256 * j);
                v2u w; w.x = pk2(hh[0], hh[1]); w.y = pk2(hh[2], hh[3]); *(GAS v2u*)(ho + 256 * j) = w; }
        }
    }
}

__device__ __forceinline__ void ld8(const bf16* p, float (&o)[8]) { const v4u w = *(const GAS v4u*)p; o[0] = bflo(w.x); o[1] = bfhi(w.x); o[2] = bflo(w.y); o[3] = bfhi(w.y); o[4] = bflo(w.z); o[5] = bfhi(w.z); o[6] = bflo(w.w); o[7] = bfhi(w.w); }
__device__ __forceinline__ void st8(bf16* p, const float (&o)[8]) { v4u w; w.x = pk2(o[0], o[1]); w.y = pk2(o[2], o[3]); w.z = pk2(o[4], o[5]); w.w = pk2(o[6], o[7]); *(GAS v4u*)p = w; }
__device__ __forceinline__ void ldf8(const float* p, float (&o)[8]) { const f32x4 a = *(const f32x4*)p, b = *(const f32x4*)(p + 4); o[0] = a[0]; o[1] = a[1]; o[2] = a[2]; o[3] = a[3]; o[4] = b[0]; o[5] = b[1]; o[6] = b[2]; o[7] = b[3]; }
__device__ __forceinline__ void p_prep_a(int l) {
    KA A = kargs(); const Frame F = mk_frame(A);
    const int gw = F.vcu * NWAVES + F.wave, NGW = F.G * NWAVES, lane = F.lane;
    const bf16* U = (const bf16*)(F.ws + WS_U); bf16* RKV = (bf16*)(F.ws + WS_RKV); bf16* L = (bf16*)(F.ws + WS_L);
    bf16* Q = (bf16*)(F.ws + WS_Q); bf16* KB = (bf16*)(F.ws + WS_KB); bf16* VB = (bf16*)(F.ws + WS_VB);
    const float* cw = A->in[I_CONVW] + (size_t)l * 3 * RWKV_COLS; const float* qn = A->in[I_QN] + l * 64; const float* kn = A->in[I_KN] + l * 64;
    const float2* rope = (const float2*)(F.ws + WS_ROPE);
    for (int row = gw; row < MR; row += NGW) {
        const int p = row % TP; const bool isctx = p < TCX;
        const bool hp = (p != 0 && p != TCX), hn = (p != TCX - 1 && p != TP - 1);
        const bf16* u0 = U + (size_t)row * UC;
#pragma unroll 1
        for (int i = 0; i < 4; ++i) { const int s = 64 * i + lane; if (s < 244) { const int c0 = 8 * s;
            float a[8], bm[8], bp[8], w0[8], w1[8], w2[8], o[8];
            ld8(u0 + c0, a); if (hp) ld8(u0 - UC + c0, bm); if (hn) ld8(u0 + UC + c0, bp);
            ldf8(cw + c0, w0); ldf8(cw + RWKV_COLS + c0, w1); ldf8(cw + 2 * RWKV_COLS + c0, w2);
#pragma unroll
            for (int e = 0; e < 8; ++e) o[e] = (hp ? bm[e] * w0[e] : 0.f) + a[e] * w1[e] + (hn ? bp[e] * w2[e] : 0.f);
            if (c0 < 1536) st8(RKV + (size_t)row * 1536 + c0, o);
            else { const int lo = c0 - 1536;
                if (lo < 160) {
#pragma unroll
                    for (int e = 0; e < 8; ++e) o[e] = sigm(o[e]); }
                else if (lo < 288) {
#pragma unroll
                    for (int e = 0; e < 8; ++e) o[e] = 1.0f - 2.0f / (1.0f + __expf(2.0f * o[e])); }
                st8(L + (size_t)row * 512 + lo, o); } } }
        if (lane >= 52) *(GAS v4u*)(L + (size_t)row * 512 + 8 * lane) = (v4u){0u, 0u, 0u, 0u};
        const int m = lane & 7, ax = m >> 2, hf = (m >> 1) & 1;
        float cs[8], sn[8];
        if (!isctx) { const float2* rp = rope + (size_t)(p - TCX) * 32 + ax * 16 + 8 * (m & 1);
#pragma unroll
            for (int e = 0; e < 8; e += 2) { const f32x4 t = *(const f32x4*)(rp + e); cs[e] = t[0]; sn[e] = t[1]; cs[e + 1] = t[2]; sn[e + 1] = t[3]; } }
        else {
#pragma unroll
            for (int e = 0; e < 8; ++e) { cs[e] = 1.f; sn[e] = 0.f; } }
        {
            float q[8], g[8]; ld8(u0 + U_Q + 8 * lane, q); ldf8(qn + 8 * m, g);
            float ss = 0.f;
#pragma unroll
            for (int e = 0; e < 8; ++e) ss += q[e] * q[e];
            const float rinv = 1.0f / sqrtf(sum8(ss) * (1.0f / 64.0f) + NORM_EPS);
#pragma unroll
            for (int e = 0; e < 8; ++e) q[e] = q[e] * rinv * g[e];
            float o[8];
#pragma unroll
            for (int e = 0; e < 8; ++e) { const float pr = __shfl_xor(q[e], 2); o[e] = (hf == 0 ? q[e] * cs[e] - pr * sn[e] : q[e] * cs[e] + pr * sn[e]) * QSCALE; }
            st8(Q + (size_t)row * 512 + 8 * lane, o);
        }
        {
            const int sl = lane & 15;
            float k[8], g[8]; ld8(u0 + U_KQ + 8 * sl, k); ldf8(kn + 8 * m, g);
            float ss = 0.f;
#pragma unroll
            for (int e = 0; e < 8; ++e) ss += k[e] * k[e];
            const float rinv = 1.0f / sqrtf(sum8(ss) * (1.0f / 64.0f) + NORM_EPS);
#pragma unroll
            for (int e = 0; e < 8; ++e) k[e] = k[e] * rinv * g[e];
            float o[8];
#pragma unroll
            for (int e = 0; e < 8; ++e) { const float pr = __shfl_xor(k[e], 2); o[e] = (hf == 0 ? k[e] * cs[e] - pr * sn[e] : k[e] * cs[e] + pr * sn[e]); }
            if (lane < 16) st8(KB + (size_t)row * 128 + 8 * sl, o);
            else if (lane < 32) *(GAS v4u*)(VB + (size_t)row * 128 + 8 * sl) = *(const GAS v4u*)(u0 + U_VQ + 8 * sl);
        }
    }
}

__device__ __forceinline__ void p_post(int l) {
    KA A = kargs(); const Frame F = mk_frame(A);
    const int gw = F.vcu * NWAVES + F.wave, NGW = F.G * NWAVES, lane = F.lane, c0 = 8 * lane;
    const float* Y = (const float*)(F.ws + WS_Y); const bf16* RKV = (const bf16*)(F.ws + WS_RKV); const bf16* LO = (const bf16*)(F.ws + WS_LO); bf16* YR = (bf16*)(F.ws + WS_YR);
    float gg[8], gb[8], ka[8], rho[8];
    ldf8(A->in[I_GNG] + l * 512 + c0, gg); ldf8(A->in[I_GNB] + l * 512 + c0, gb); ldf8(A->in[I_KEYA] + l * 512 + c0, ka); ldf8(A->in[I_RHO] + l * 512 + c0, rho);
    for (int row = gw; row < MR; row += NGW) {
        if (l == NLAYER - 1 && (row % TP) < TCX) continue;
        float y[8], y1[8]; ldf8(Y + (size_t)row * 512 + c0, y); ldf8(Y + ((size_t)MR + row) * 512 + c0, y1);
        float s = 0.f;
#pragma unroll
        for (int e = 0; e < 8; ++e) { y[e] += y1[e]; s += y[e]; }
        const float mu = sum8(s) * (1.0f / 64.0f); float q = 0.f;
#pragma unroll
        for (int e = 0; e < 8; ++e) { y[e] -= mu; q += y[e] * y[e]; }
        const float rstd = 1.0f / sqrtf(sum8(q) * (1.0f / 64.0f) + GN_EPS);
        float r[8], k[8], v[8], a0[8], a1[8], g[8];
        ld8(RKV + (size_t)row * 1536 + c0, r); ld8(RKV + (size_t)row * 1536 + 512 + c0, k); ld8(RKV + (size_t)row * 1536 + 1024 + c0, v);
        ld8(LO + (size_t)row * LOC + 1536 + c0, a0); ld8(LO + (size_t)row * LOC + 2048 + c0, a1); ld8(LO + (size_t)row * LOC + c0, g);
        float bs = 0.f;
#pragma unroll
        for (int e = 0; e < 8; ++e) { const float kr = k[e] * (1.0f + (a0[e] - 1.0f) * ka[e]) + k[e] * (1.0f + (a1[e] - 1.0f) * ka[e]); bs += r[e] * kr * rho[e]; }
        const float bon = sum8(bs);
        float o[8];
#pragma unroll
        for (int e = 0; e < 8; ++e) o[e] = ((y[e] * rstd * gg[e] + gb[e]) + bon * v[e]) * g[e];
        st8(YR + (size_t)row * 512 + c0, o);
    }
}

__device__ __forceinline__ void p_norm2(int l) {
    KA A = kargs(); const Frame F = mk_frame(A);
    const int gw = F.vcu * NWAVES + F.wave, NGW = F.G * NWAVES, lane = F.lane;
    LAS float* WRt = (LAS float*)(F.lds);
    for (int i = F.tid; i < 16 * 1024; i += NWAVES * 64) { const int c = i >> 4, e = i & 15; WRt[e * 1024 + c] = A->in[I_WROUTER][(size_t)l * DM * 16 + i]; }
    __syncthreads();
    const float* X = (const float*)(F.ws + WS_X); bf16* H = (bf16*)(F.ws + WS_H); float* AFF = (float*)(F.ws + WS_AFF);
    const float* modv = (const float*)(F.ws + WS_MODV);
    for (int row = gw; row < MR; row += NGW) {
        const int b = row / TP, p = row % TP, sel = p < TCX ? 4 : b;
        if (l == NLAYER - 1 && p < TCX) continue;
        f32x4 v[4]; float ss = 0.f;
#pragma unroll
        for (int j = 0; j < 4; ++j) { v[j] = *(const GAS f32x4*)(X + (size_t)row * DM + 4 * lane + 256 * j); ss += (v[j][0] * v[j][0] + v[j][1] * v[j][1]) + (v[j][2] * v[j][2] + v[j][3] * v[j][3]); }
        const float rinv = 1.0f / sqrtf(wave_sum(ss) * (1.0f / DM) + NORM_EPS);
        const float* nw = A->in[I_NFFN] + l * DM + 4 * lane; const float* sh = modv + ((size_t)l * 5 + sel) * 6144 + 3 * 1024 + 4 * lane; const float* sc = sh + 1024;
        bf16* ho = H + (size_t)row * DM + 4 * lane;
#pragma unroll
        for (int j = 0; j < 4; ++j) { v[j] = v[j] * rinv * *(const f32x4*)(nw + 256 * j) * (1.0f + *(const f32x4*)(sc + 256 * j)) + *(const f32x4*)(sh + 256 * j);
            v2u w; w.x = pk2(v[j][0], v[j][1]); w.y = pk2(v[j][2], v[j][3]); *(GAS v2u*)(ho + 256 * j) = w; }
        float lg[16];
#pragma unroll
        for (int e = 0; e < 16; ++e) { float s = 0.f;
#pragma unroll
            for (int j = 0; j < 4; ++j) { const f32x4 w = *(const LAS f32x4*)(WRt + e * 1024 + 4 * lane + 256 * j); s += (v[j][0] * w[0] + v[j][1] * w[1]) + (v[j][2] * w[2] + v[j][3] * w[3]); }
            lg[e] = wave_sum(s); }
        float mx = lg[0];
#pragma unroll
        for (int e = 1; e < 16; ++e) mx = fmaxf(mx, lg[e]);
        float den = 0.f;
#pragma unroll
        for (int e = 0; e < 16; ++e) { lg[e] = expf(lg[e] - mx); den += lg[e]; }
        float mine = lg[0];
#pragma unroll
        for (int e = 1; e < 16; ++e) mine = (lane == e) ? lg[e] : mine;
        if (lane < 16) AFF[(size_t)row * 16 + lane] = mine / den;
    }
    __syncthreads();
}

__device__ __forceinline__ int block_excl_scan(int v, LAS int* tmp, int tid, int lane, int wave, int& total) {
    int inc = v;
#pragma unroll
    for (int o = 1; o < 64; o <<= 1) { const int t = __shfl_up(inc, o); if (lane >= o) inc += t; }
    __syncthreads();
    if (lane == 63) tmp[wave] = inc;
    __syncthreads();
    int base = 0, tot = 0;
#pragma unroll
    for (int w = 0; w < NWAVES; ++w) { const int t = tmp[w]; if (w < wave) base += t; tot += t; }
    total = tot;
    return base + inc - v;
}
__device__ __forceinline__ void p_topk(int l) {
    KA A = kargs(); const Frame F = mk_frame(A);
    LAS int* hist = (LAS int*)(F.lds);
    LAS int* hist2 = hist + 256;
    LAS int* sel = hist + 512;
    LAS int* tmp = hist + 528;
    const float* AFF = (const float*)(F.ws + WS_AFF); int* TOKMAP = (int*)(F.ws + WS_TOKMAP); int* IDX = (int*)(F.ws + WS_IDX); float* GATEV = (float*)(F.ws + WS_GATEV);
    const int nprob = (l == 0) ? 128 : 64, tid = F.tid;
    for (int pid = blockIdx.x; pid < nprob; pid += F.G) {
        const bool isc = pid >= 64; const int q = pid & 63, b = q >> 4, e = q & 15;
        const int n = isc ? TCX : TL, C = isc ? CAP_C : CAP_L, rowbase = b * TP + (isc ? 0 : TCX);
        const int slotbase = isc ? (SLOT_L + e * 256 + b * CAP_C) : (e * (NB * CAP_L) + b * CAP_L);
        const int t0 = 16 * tid; const bool valid = t0 < n;
        unsigned key[16];
#pragma unroll
        for (int k = 0; k < 16; ++k) key[k] = valid ? __float_as_uint(AFF[(size_t)(rowbase + t0 + k) * 16 + e]) : 0u;
        unsigned prefix = 0u, mask = 0u; int remaining = C;
#pragma unroll 1
        for (int pass = 0; pass < 4; ++pass) { const int shift = 24 - 8 * pass;
            if (tid < 256) hist[tid] = 0;
            __syncthreads();
            if (valid) {
#pragma unroll
                for (int k = 0; k < 16; ++k) if ((key[k] & mask) == prefix) atomicAdd((int*)&hist[(key[k] >> shift) & 255u], 1); }
            __syncthreads();
            LAS int* src = hist; LAS int* dst = hist2;
#pragma unroll 1
            for (int off = 1; off < 256; off <<= 1) { if (tid < 256) dst[tid] = src[tid] + (tid + off < 256 ? src[tid + off] : 0); __syncthreads(); LAS int* t = src; src = dst; dst = t; }
            if (tid < 256) { const int sd = src[tid], sn = tid < 255 ? src[tid + 1] : 0; if (sd >= remaining && sn < remaining) { sel[0] = tid; sel[1] = remaining - sn; } }
            __syncthreads();
            prefix |= (unsigned)sel[0] << shift; mask |= 255u << shift; remaining = sel[1];
            __syncthreads();
        }
        int ceq = 0;
#pragma unroll
        for (int k = 0; k < 16; ++k) ceq += (valid && key[k] == prefix) ? 1 : 0;
        int tot; int eqrank = block_excl_scan(ceq, tmp, tid, F.lane, F.wave, tot);
        unsigned selmask = 0u; int csel = 0;
#pragma unroll
        for (int k = 0; k < 16; ++k) { bool s = false; if (valid) { if (key[k] > prefix) s = true; else if (key[k] == prefix) { s = eqrank < remaining; ++eqrank; } } if (s) { selmask |= 1u << k; ++csel; } }
        int pos = block_excl_scan(csel, tmp, tid, F.lane, F.wave, tot);
        if (valid) {
#pragma unroll
            for (int k = 0; k < 16; ++k) { const int row = rowbase + t0 + k;
                if (selmask & (1u << k)) { const int sr = slotbase + pos; ++pos; IDX[sr] = row; GATEV[sr] = __uint_as_float(key[k]); TOKMAP[(size_t)row * 16 + e] = sr; }
                else TOKMAP[(size_t)row * 16 + e] = -1; } }
        if (isc && b == 0 && tid >= 128 && tid < 256) { IDX[SLOT_L + e * 256 + tid] = -1; GATEV[SLOT_L + e * 256 + tid] = 0.f; }
        __syncthreads();
    }
}

__device__ __forceinline__ void p_gather(int l) {
    KA A = kargs(); const Frame F = mk_frame(A);
    const int gw = F.vcu * NWAVES + F.wave, NGW = F.G * NWAVES, lane = F.lane;
    const bf16* H = (const bf16*)(F.ws + WS_H); bf16* XE = (bf16*)(F.ws + WS_XE); const int* IDX = (const int*)(F.ws + WS_IDX);
    const int ns = (l == 0) ? SLOT_ALL : SLOT_L;
    for (int sr = gw; sr < ns; sr += NGW) { const int idx = IDX[sr];
        v4u a = (v4u){0u, 0u, 0u, 0u}, b2 = a;
        if (idx >= 0) { a = *(const GAS v4u*)(H + (size_t)idx * DM + 8 * lane); b2 = *(const GAS v4u*)(H + (size_t)idx * DM + 512 + 8 * lane); }
        *(GAS v4u*)(XE + (size_t)sr * DM + 8 * lane) = a; *(GAS v4u*)(XE + (size_t)sr * DM + 512 + 8 * lane) = b2; }
}
constexpr int SC_CH = 32, SC_STR = 336, SC_NC = TP / SC_CH;
__device__ __forceinline__ int scan_p(int s, int z) { return z == 0 ? s : (s < TCX ? (TCX - 1 - s) : (TP + TCX - 1 - s)); }
#define DPP_ROR_ADD(x, n) (x) += __builtin_bit_cast(float, __builtin_amdgcn_update_dpp(0, __builtin_bit_cast(int, (x)), 0x120 + (n), 0xf, 0xf, false))
__device__ __forceinline__ float red16(float x) { DPP_ROR_ADD(x, 8); DPP_ROR_ADD(x, 4); DPP_ROR_ADD(x, 2); DPP_ROR_ADD(x, 1); return x; }
#define SC_BAR() asm volatile("s_waitcnt lgkmcnt(0)\n\ts_barrier" ::: "memory")
__device__ __forceinline__ void scan_load_chunk(const Frame& F, KA A, int l, int c, int b, int h, int z, int rg, const bf16* RKV, const bf16* LO, float keyk, float keya) {
    const int lw = F.wave - 4, lane = F.lane, hc = h * 64 + lane;
    LAS float* ops = (LAS float*)(F.lds) + (c & 1) * (SC_CH * SC_STR);
    float kx[8], rx[8], ax[8], wx[8], vx[8];
#pragma unroll
    for (int q = 0; q < 8; ++q) { const int i = lw + 4 * q, s = c * SC_CH + i; const size_t row = (size_t)b * TP + scan_p(s, z);
        kx[q] = bf1(RKV[row * 1536 + 512 + hc]); rx[q] = bf1(RKV[row * 1536 + hc]); ax[q] = bf1(LO[row * LOC + 1536 + 512 * z + hc]);
        wx[q] = (float)__builtin_bit_cast(_Float16, LO[row * LOC + 512 + 512 * z + hc]);
        vx[q] = bf1(RKV[row * 1536 + 1024 + h * 64 + 16 * rg + (lane & 15)]); }
#pragma unroll
    for (int q = 0; q < 8; ++q) { const int i = lw + 4 * q; LAS float* base = ops + i * SC_STR;
        const float kkr = kx[q] * keyk; const float ss = wave_sum(kkr * kkr); const float kk = kkr * (1.0f / sqrtf(ss + 1e-12f));
        base[lane] = kk; base[64 + lane] = wx[q]; base[128 + lane] = kk * ax[q]; base[192 + lane] = kx[q] * (1.0f + (ax[q] - 1.0f) * keya); base[256 + lane] = rx[q];
        if (lane < 16) base[320 + lane] = vx[q]; }
}
__device__ __forceinline__ void p_scan(int l) {
    KA A = kargs(); const Frame F = mk_frame(A);
    const bf16* RKV = (const bf16*)(F.ws + WS_RKV); const bf16* LO = (const bf16*)(F.ws + WS_LO); float* Y = (float*)(F.ws + WS_Y);
    const int lane = F.lane;
    for (int task = blockIdx.x; task < 256; task += F.G) {
        const int chain = task >> 2, rg = task & 3, b = chain >> 4, h = (chain >> 1) & 7, z = chain & 1;
        if (F.wave >= 4) {
            const float keyk = A->in[I_KEYK][l * 512 + h * 64 + lane], keya = A->in[I_KEYA][l * 512 + h * 64 + lane];
            scan_load_chunk(F, A, l, 0, b, h, z, rg, RKV, LO, keyk, keya);
            SC_BAR();
#pragma unroll 1
            for (int c = 0; c < SC_NC; ++c) { if (c + 1 < SC_NC) scan_load_chunk(F, A, l, c + 1, b, h, z, rg, RKV, LO, keyk, keya); SC_BAR(); }
        } else {
            const int r = lane >> 4, j = lane & 15, cw = F.wave;
            f32x4 S = (f32x4){0.f, 0.f, 0.f, 0.f};
            float* yout = Y + ((size_t)z * MR + (size_t)b * TP) * 512 + h * 64 + 16 * rg + 4 * cw + r;
            SC_BAR();
#pragma unroll 1
            for (int c = 0; c < SC_NC; ++c) {
                const LAS float* ops = (const LAS float*)(F.lds) + (c & 1) * (SC_CH * SC_STR);
#pragma unroll 1
                for (int hf = 0; hf < SC_CH / 16; ++hf) {
                    float ykeep = 0.f;
#pragma unroll
                    for (int ii = 0; ii < 16; ++ii) { const LAS float* base = ops + (hf * 16 + ii) * SC_STR;
                        const f32x4 kk4 = *(const LAS f32x4*)(base + 4 * j), w4 = *(const LAS f32x4*)(base + 64 + 4 * j), ka4 = *(const LAS f32x4*)(base + 128 + 4 * j),
                                    kr4 = *(const LAS f32x4*)(base + 192 + 4 * j), r4 = *(const LAS f32x4*)(base + 256 + 4 * j);
                        const float vv = base[320 + 4 * cw + r];
                        const float rem = red16((S[0] * kk4[0] + S[1] * kk4[1]) + (S[2] * kk4[2] + S[3] * kk4[3]));
                        S = S * w4 + (vv * kr4 - rem * ka4);
                        const float y = red16((S[0] * r4[0] + S[1] * r4[1]) + (S[2] * r4[2] + S[3] * r4[3]));
                        ykeep = (j == ii) ? y : ykeep; }
                    const int s = c * SC_CH + hf * 16 + j;
                    yout[(size_t)scan_p(s, z) * 512] = ykeep;
                }
                SC_BAR();
            }
        }
    }
    __syncthreads();
}

__device__ __forceinline__ void p_attn(char* lds, int l) {
    KA A = kargs(); const Frame F = mk_frame(A);
    const attn_body::bf16* Q = (const attn_body::bf16*)(F.ws + WS_Q); const attn_body::bf16* K = (const attn_body::bf16*)(F.ws + WS_KB); const attn_body::bf16* V = (const attn_body::bf16*)(F.ws + WS_VB);
    const int NU = 1024 + (l == 0 ? 32 : 0);
    for (int u = F.vcu; u < NU; u += F.G) {
        if (u < 1024) { const int i = u >> 8, v = u & 255, bh = v >> 3, s = v & 7, b = bh >> 3, h = bh & 7;
            const int qb = (i == 0) ? s : (i == 1) ? 15 - s : (i == 2) ? 16 + s : 31 - s;
            attn_body::attn_unit<8>((long)b * TP + TCX + 256 * qb, h, (long)b * TP, TP / 64, Q, K, V, (attn_body::bf16*)Q, lds);
        } else { const int c = u - 1024, b = c >> 3, h = c & 7;
            attn_body::attn_unit<8>((long)b * TP, h, (long)b * TP, TCX / 64, Q, K, V, (attn_body::bf16*)Q, lds); }
    }
}

constexpr int PH_PRO = 0, PH_PER_LAYER = 15, PH_FINAL = 1 + NLAYER * PH_PER_LAYER, NPH = PH_FINAL + 1;
enum { O_NORM1 = 0, O_INPROJ, O_PREPA, O_LORA, O_SCAN, O_ATTN, O_POST, O_MG1A, O_MG1B, O_MG2, O_NORM2, O_TOPK, O_GATHER, O_MUP, O_MDOWN };
__device__ __forceinline__ void ph_inproj(int l) { KA A = kargs(); const Frame F = mk_frame(A);
    pg8::Gemm g{(const bf16*)(F.ws + WS_H), (const bf16*)(F.ws + WS_WIN) + (size_t)l * UC * DM, MR, UC, DM}; pg8::StaticOrder S; S.init(MR, UC, F.G, lbid());
    pg8::EpiStore E{(bf16*)(F.ws + WS_U), UC}; pg8::gemm_phase<pg8::EpiStore, pg8::StaticOrder, true, true>(F.lds + RING_OFF, g, S, E); }
__device__ __forceinline__ void ph_lora(int l) { KA A = kargs(); const Frame F = mk_frame(A);
    pg8::Gemm g{(const bf16*)(F.ws + WS_L), (const bf16*)(F.ws + WS_WLORA) + (size_t)l * LOC * 512, MR, LOC, 512}; pg8::StaticOrder S; S.init(MR, LOC, F.G, lbid());
    pg8::EpiLora E{(bf16*)(F.ws + WS_LO), LOC, A->in[I_DW0] + l * 1024, A->in[I_A0] + l * 1024}; pg8::gemm_phase<pg8::EpiLora, pg8::StaticOrder, true, true>(F.lds + RING_OFF, g, S, E); }
__device__ __forceinline__ void ph_mg1a(int l) { KA A = kargs(); const Frame F = mk_frame(A);
    pg8::Gemm g{(const bf16*)(F.ws + WS_YR), (const bf16*)(F.ws + WS_WBR) + (size_t)l * DM * 512, MR, DM, 512}; pg8::StaticOrder S; S.init(MR, DM, F.G, lbid());
    pg8::EpiMerge1<0> E{(const bf16*)(F.ws + WS_U) + U_GR, UC, (float*)(F.ws + WS_P1), (bf16*)(F.ws + WS_M1)}; pg8::gemm_phase<pg8::EpiMerge1<0>, pg8::StaticOrder, true, true>(F.lds + RING_OFF, g, S, E); }
__device__ __forceinline__ void ph_mg1b(int l) { KA A = kargs(); const Frame F = mk_frame(A);
    pg8::Gemm g{(const bf16*)(F.ws + WS_Q), (const bf16*)(F.ws + WS_WBA) + (size_t)l * DM * 512, MR, DM, 512}; pg8::StaticOrder S; S.init(MR, DM, F.G, lbid());
    pg8::EpiMerge1<1> E{(const bf16*)(F.ws + WS_U) + U_GA, UC, (float*)(F.ws + WS_P1), (bf16*)(F.ws + WS_M1)}; pg8::gemm_phase<pg8::EpiMerge1<1>, pg8::StaticOrder, true, true>(F.lds + RING_OFF, g, S, E); }
__device__ __forceinline__ void ph_mg2(int l) { KA A = kargs(); const Frame F = mk_frame(A);
    pg8::Gemm g{(const bf16*)(F.ws + WS_M1), (const bf16*)(F.ws + WS_WOUT) + (size_t)l * DM * DM, MR, DM, DM}; pg8::StaticOrder S; S.init(MR, DM, F.G, lbid());
    pg8::EpiResid E{(float*)(F.ws + WS_X), (const float*)(F.ws + WS_MODV) + (size_t)l * 5 * 6144}; pg8::gemm_phase<pg8::EpiResid, pg8::StaticOrder, true, true>(F.lds + RING_OFF, g, S, E); }
__device__ __forceinline__ void ph_mup(int l) { KA A = kargs(); const Frame F = mk_frame(A); const int nM = (l == 0) ? SLOT_ALL / 256 : SLOT_L / 256;
    pg8::Gemm g{(const bf16*)(F.ws + WS_XE), (const bf16*)(F.ws + WS_WGU), nM * 256, 2 * FF, DM}; pg8::MoeOrder S; S.init(nM, 2 * FF / 256, F.G, lbid());
    pg8::EpiMoeUp E{(bf16*)(F.ws + WS_HID), FF}; pg8::gemm_phase<pg8::EpiMoeUp, pg8::MoeOrder, true, true>(F.lds + RING_OFF, g, S, E); }
__device__ __forceinline__ void ph_mdown(int l) { KA A = kargs(); const Frame F = mk_frame(A); const int nM = (l == 0) ? SLOT_ALL / 256 : SLOT_L / 256;
    pg8::Gemm g{(const bf16*)(F.ws + WS_HID), (const bf16*)(F.ws + WS_WD), nM * 256, DM, FF}; pg8::MoeOrder S; S.init(nM, DM / 256, F.G, lbid());
    pg8::EpiMoeDown E{(bf16*)(F.ws + WS_XE), (const float*)(F.ws + WS_GATEV)}; pg8::gemm_phase<pg8::EpiMoeDown, pg8::MoeOrder, true, true>(F.lds + RING_OFF, g, S, E); }

__global__ void __launch_bounds__(NWAVES * 64, 2) fwd(Args args) {
    extern __shared__ __attribute__((aligned(16))) unsigned char lds[];
    {   LAS unsigned char* l3 = (LAS unsigned char*)lds;
        for (int u = threadIdx.x; u < (LDS_BYTES - LDSCTL_OFF) / 4; u += NWAVES * 64) ((LAS unsigned*)(l3 + LDSCTL_OFF))[u] = 0u; }
    __syncthreads();
    const int lo = args.ph_lo, hi = args.ph_hi, use_bar = args.use_bar;
    XcdBarrier bar; bar.bar = (unsigned*)(args.ws + WS_CTL) + CW_BAR; bar.x = 0; bar.st = nullptr;
    if (use_bar) bar = xcd_barrier_post((unsigned*)(args.ws + WS_CTL) + CW_BAR, (volatile LAS unsigned*)((LAS unsigned char*)lds + MISC_OFF) + 8);
#define IN(k) (lo <= (k) && (k) < hi)
#define SEAM(k) do { if (IN(k) && IN((k) + 1) && use_bar) xcd_barrier(bar); } while (0)
    if (IN(PH_PRO)) { p_prologue(); }
    SEAM(PH_PRO);
#pragma unroll 1
    for (int l = 0; l < NLAYER; ++l) {
        const int pb = 1 + l * PH_PER_LAYER;
        if (IN(pb + O_NORM1)) { if (l == 0) p_rownorm<0>(); else { p_rownorm<1>(); KA A = kargs(); const Frame F = mk_frame(A); cvt_moe(F, A, 1); } }
        SEAM(pb + O_NORM1);
        if (IN(pb + O_INPROJ)) ph_inproj(l);
        SEAM(pb + O_INPROJ);
        if (IN(pb + O_PREPA)) p_prep_a(l);
        SEAM(pb + O_PREPA);
        if (IN(pb + O_LORA)) ph_lora(l);
        SEAM(pb + O_LORA);
        if (IN(pb + O_SCAN)) p_scan(l);
        if (IN(pb + O_ATTN)) p_attn((char*)lds + RING_OFF, l);
        SEAM(pb + O_ATTN);
        if (IN(pb + O_POST)) p_post(l);
        SEAM(pb + O_POST);
        if (IN(pb + O_MG1A)) ph_mg1a(l);
        SEAM(pb + O_MG1A);
        if (IN(pb + O_MG1B)) ph_mg1b(l);
        SEAM(pb + O_MG1B);
        if (IN(pb + O_MG2)) ph_mg2(l);
        SEAM(pb + O_MG2);
        if (IN(pb + O_NORM2)) p_norm2(l);
        SEAM(pb + O_NORM2);
        if (IN(pb + O_TOPK)) p_topk(l);
        SEAM(pb + O_TOPK);
        if (IN(pb + O_GATHER)) p_gather(l);
        SEAM(pb + O_GATHER);
        if (IN(pb + O_MUP)) ph_mup(l);
        SEAM(pb + O_MUP);
        if (IN(pb + O_MDOWN)) ph_mdown(l);
        SEAM(pb + O_MDOWN);
    }
    if (IN(PH_FINAL)) { p_rownorm<2>(); }
#undef IN
#undef SEAM
}

extern "C" void kernel_launch(void* const* d_in, const int* in_sizes, int n_in, void* d_out, int out_size, void* d_ws, size_t ws_size, hipStream_t stream) {
    static int grid = 0;
    if (grid == 0) {
        if (n_in != 30 || out_size != NB * TL * DM || ws_size < WS_END) { fprintf(stderr, "kernel_launch: unexpected problem (n_in %d, out %d, ws %zu < %zu)\n", n_in, out_size, ws_size, (size_t)WS_END); grid = -1; return; }
        int dev = 0, cus = 0, per_cu = 0;
        if (hipGetDevice(&dev) != hipSuccess || hipDeviceGetAttribute(&cus, hipDeviceAttributeMultiprocessorCount, dev) != hipSuccess) { grid = -1; return; }
        if (hipFuncSetAttribute((const void*)fwd, hipFuncAttributeMaxDynamicSharedMemorySize, LDS_BYTES) != hipSuccess) { fprintf(stderr, "kernel_launch: hipFuncSetAttribute failed\n"); grid = -1; return; }
        if (hipOccupancyMaxActiveBlocksPerMultiprocessor(&per_cu, (const void*)fwd, NWAVES * 64, LDS_BYTES) != hipSuccess || per_cu < 1) fprintf(stderr, "kernel_launch: occupancy query reports %d\n", per_cu);
        (void)hipGetLastError();
        grid = cus;
    }
    if (grid < 0) return;
    if (hipMemsetAsync((char*)d_ws + WS_CTL, 0, CTL_ZERO_BYTES, stream) != hipSuccess) return;
    Args a{};
    for (int i = 0; i < 30; ++i) a.in[i] = (const float*)d_in[i];
    a.out = (float*)d_out; a.ws = (unsigned char*)d_ws; a.pad = 0;
#if MK_PER_PHASE
    for (int ph = 0; ph < NPH; ++ph) { a.ph_lo = ph; a.ph_hi = ph + 1; a.use_bar = 0;
        hipLaunchKernelGGL(fwd, dim3(grid), dim3(NWAVES * 64), LDS_BYTES, stream, a); }
#else
    a.ph_lo = 0; a.ph_hi = NPH; a.use_bar = 1;
    hipLaunchKernelGGL(fwd, dim3(grid), dim3(NWAVES * 64), LDS_BYTES, stream, a);
#endif
}
```

```cpp
#include <hip/hip_runtime.h>
#include <hip/hip_bf16.h>
#include <cstdio>
#include <cstdint>
#include <cmath>

#ifndef PROBE_MASK
#define PROBE_MASK 0ull
#endif
#ifndef MK_PER_PHASE
#define MK_PER_PHASE 0
#endif

__device__ __forceinline__ int ltid() { int t = threadIdx.x; asm volatile("" : "+v"(t)); return t; }
__device__ __forceinline__ int lbid() { int b = blockIdx.x; asm volatile("" : "+s"(b)); return b; }
namespace pg8 {
#define PG8_LAS __attribute__((address_space(3)))
typedef unsigned short bf16_t;
typedef short bf16x8 __attribute__((ext_vector_type(8)));
typedef float f32x4 __attribute__((ext_vector_type(4)));
typedef unsigned u32x4 __attribute__((ext_vector_type(4)));
constexpr int BM = 256, BK = 64, HALF = 128, HTB = HALF * BK * 2  , STAGE_BYTES = 8 * HTB, NXCD = 8, WGM = 8;

__host__ __device__ __forceinline__ int lds_byte(int r, int c) { const int st = (r >> 4) * 2 + (c >> 5), rr = r & 15, cc = c & 31, ob = rr * 64 + cc * 2; return st * 1024 + (ob ^ (((ob >> 9) & 1) << 5)); }
__host__ __device__ __forceinline__ void stage_rc(int b, int& R, int& C) { const int st = b / 1024, sb = b % 1024, swz = sb ^ (((sb >> 9) & 1) << 5); R = (st >> 1) * 16 + swz / 64; C = (st & 1) * 32 + (swz % 64) / 2; }
__host__ __device__ __forceinline__ int perm32(int rho) { const int n = rho >> 4, i = rho & 15; return 8 * (i >> 2) + 4 * n + (i & 3); }

struct Unit { int pm, pn, pb, k0, nt, cont; };
struct Gemm { const bf16_t* A; const bf16_t* Bt; int M, N, K, lda, ldb; };

struct StaticOrder {
    static constexpr bool GATHER = false; __device__ __forceinline__ int arow(int r) const { return r; }
    int nM, nN, nwg, G, c, skip, ntk;
    __host__ __device__ void init(int M, int N, int G_, int c_, int skip_ = 0, int K_ = 0) { ntk = K_ / BK; skip = skip_; nM = M / BM - (skip_ ? 4 : 0); nN = N / BM; nwg = nM * nN; G = G_; c = c_; }
    __host__ __device__ bool next(int i, Unit& u) const {
        const long L = (long)i * G + c; if (L >= nwg) return false;
        int wgid = (int)L; { const int q = nwg / NXCD, r = nwg % NXCD, xcd = wgid % NXCD, off = wgid / NXCD; wgid = (xcd < r ? xcd * (q + 1) : r * (q + 1) + (xcd - r) * q) + off; }
        const int nig = WGM * nN, gid = wgid / nig, fm = gid * WGM, gsz = (nM - fm) < WGM ? (nM - fm) : WGM;
        u.pm = fm + ((wgid % nig) % gsz); u.pn = (wgid % nig) / gsz; u.pb = u.pn; u.k0 = 0; u.nt = ntk; u.cont = 0; if (skip) u.pm += (u.pm >> 5) + 1; return true;
    }
    __device__ __forceinline__ void a_ready(const Unit&) const {}
    __device__ __forceinline__ void done(const Unit&) const {}
};

__device__ __forceinline__ unsigned cvt_pk_bf16(float lo, float hi) { unsigned r; asm volatile("v_cvt_pk_bf16_f32 %0, %1, %2" : "=v"(r) : "v"(lo), "v"(hi)); return r; }
__device__ __forceinline__ float bf_lo(unsigned u) { return __uint_as_float(u << 16); }
__device__ __forceinline__ float bf_hi(unsigned u) { return __uint_as_float(u & 0xffff0000u); }
__device__ __forceinline__ float fsigmoid(float x) { return __builtin_amdgcn_rcpf(1.0f + __expf(-x)); }
__device__ __forceinline__ unsigned pk_f16(float lo, float hi) { const _Float16 a = (_Float16)lo, b = (_Float16)hi; return (unsigned)__builtin_bit_cast(unsigned short, a) | ((unsigned)__builtin_bit_cast(unsigned short, b) << 16); }

struct EpiStore {
    static constexpr bool PERM = true, AFTER_DRAIN = false;
    bf16_t* O; int ldc;
    __device__ __forceinline__ void operator()(const f32x4 (&acc)[2][2][4][2], const Unit& u, int wr, int wc, int fr, int fq) const {
        const int row0 = u.pm * BM + wr * 64 + fr, col0 = u.pn * BM + wc * 32 + 8 * fq;
#pragma unroll
        for (int ai = 0; ai < 2; ++ai)
#pragma unroll
            for (int m = 0; m < 4; ++m) { bf16_t* rowp = O + (size_t)(row0 + ai * HALF + m * 16) * ldc + col0;
#pragma unroll
                for (int bj = 0; bj < 2; ++bj) { const f32x4 v0 = acc[ai][bj][m][0], v1 = acc[ai][bj][m][1];
                    u32x4 w; w.x = cvt_pk_bf16(v0[0], v0[1]); w.y = cvt_pk_bf16(v0[2], v0[3]); w.z = cvt_pk_bf16(v1[0], v1[1]); w.w = cvt_pk_bf16(v1[2], v1[3]);
                    *(u32x4*)(rowp + bj * HALF) = w; } }
    }
};
struct EpiLora {
    static constexpr bool PERM = true, AFTER_DRAIN = false;
    bf16_t* O; int ldc; const float* w0; const float* a0;
    __device__ __forceinline__ void operator()(const f32x4 (&acc)[2][2][4][2], const Unit& u, int wr, int wc, int fr, int fq) const {
        const int row0 = u.pm * BM + wr * 64 + fr, col0 = u.pn * BM + wc * 32 + 8 * fq;
        const int typ = u.pn < 2 ? 0 : (u.pn < 6 ? 1 : 2);
        f32x4 bv[2][2];
#pragma unroll
        for (int bj = 0; bj < 2; ++bj)
#pragma unroll
            for (int n = 0; n < 2; ++n) { const int c = col0 + bj * HALF + 4 * n;
                bv[bj][n] = typ == 0 ? (f32x4){0.f, 0.f, 0.f, 0.f} : (typ == 1 ? *(const f32x4*)(w0 + (c - 512)) : *(const f32x4*)(a0 + (c - 1536))); }
#pragma unroll
        for (int ai = 0; ai < 2; ++ai)
#pragma unroll
            for (int m = 0; m < 4; ++m) { bf16_t* rowp = O + (size_t)(row0 + ai * HALF + m * 16) * ldc + col0;
#pragma unroll
                for (int bj = 0; bj < 2; ++bj) { f32x4 v0 = acc[ai][bj][m][0] + bv[bj][0], v1 = acc[ai][bj][m][1] + bv[bj][1]; u32x4 w;
                    if (typ == 1) {
#pragma unroll
                        for (int i = 0; i < 4; ++i) { v0[i] = __expf(-0.6065306597126334f * fsigmoid(v0[i])); v1[i] = __expf(-0.6065306597126334f * fsigmoid(v1[i])); }
                        w.x = pk_f16(v0[0], v0[1]); w.y = pk_f16(v0[2], v0[3]); w.z = pk_f16(v1[0], v1[1]); w.w = pk_f16(v1[2], v1[3]);
                    } else {
                        if (typ == 2) {
#pragma unroll
                            for (int i = 0; i < 4; ++i) { v0[i] = fsigmoid(v0[i]); v1[i] = fsigmoid(v1[i]); } }
                        w.x = cvt_pk_bf16(v0[0], v0[1]); w.y = cvt_pk_bf16(v0[2], v0[3]); w.z = cvt_pk_bf16(v1[0], v1[1]); w.w = cvt_pk_bf16(v1[2], v1[3]);
                    }
                    *(u32x4*)(rowp + bj * HALF) = w; } }
    }
};
struct EpiMergeK {
    static constexpr bool PERM = true, AFTER_DRAIN = false;
    const bf16_t* GR; const bf16_t* GA; int ldg; bf16_t* M1;
    __device__ __forceinline__ void operator()(f32x4 (&acc)[2][2][4][2], const Unit& u, int wr, int wc, int fr, int fq) const {
        const int row0 = u.pm * BM + wr * 64 + fr, col0 = u.pn * BM + wc * 32 + 8 * fq;
        if (!u.cont) {
#pragma unroll
            for (int ai = 0; ai < 2; ++ai)
#pragma unroll
                for (int m = 0; m < 4; ++m) { const size_t row = (size_t)(row0 + ai * HALF + m * 16);
#pragma unroll
                    for (int bj = 0; bj < 2; ++bj) { const int c = col0 + bj * HALF;
                        const u32x4 rw = *(const u32x4*)(GR + row * ldg + c), aw = *(const u32x4*)(GA + row * ldg + c);
                        f32x4 s0, s1;
                        s0[0] = (1.0f + __expf(-bf_lo(aw.x))) * __builtin_amdgcn_rcpf(1.0f + __expf(-bf_lo(rw.x))); s0[1] = (1.0f + __expf(-bf_hi(aw.x))) * __builtin_amdgcn_rcpf(1.0f + __expf(-bf_hi(rw.x)));
                        s0[2] = (1.0f + __expf(-bf_lo(aw.y))) * __builtin_amdgcn_rcpf(1.0f + __expf(-bf_lo(rw.y))); s0[3] = (1.0f + __expf(-bf_hi(aw.y))) * __builtin_amdgcn_rcpf(1.0f + __expf(-bf_hi(rw.y)));
                        s1[0] = (1.0f + __expf(-bf_lo(aw.z))) * __builtin_amdgcn_rcpf(1.0f + __expf(-bf_lo(rw.z))); s1[1] = (1.0f + __expf(-bf_hi(aw.z))) * __builtin_amdgcn_rcpf(1.0f + __expf(-bf_hi(rw.z)));
                        s1[2] = (1.0f + __expf(-bf_lo(aw.w))) * __builtin_amdgcn_rcpf(1.0f + __expf(-bf_lo(rw.w))); s1[3] = (1.0f + __expf(-bf_hi(aw.w))) * __builtin_amdgcn_rcpf(1.0f + __expf(-bf_hi(rw.w)));
                        acc[ai][bj][m][0] *= s0; acc[ai][bj][m][1] *= s1; }
                    if (m & 1) asm volatile("" ::: "memory"); }
        } else {
#pragma unroll
            for (int ai = 0; ai < 2; ++ai)
#pragma unroll
                for (int m = 0; m < 4; ++m) { const size_t row = (size_t)(row0 + ai * HALF + m * 16);
#pragma unroll
                    for (int bj = 0; bj < 2; ++bj) { const int c = col0 + bj * HALF;
                        const u32x4 gw = *(const u32x4*)(GA + row * ldg + c);
                        f32x4 g0, g1; g0[0] = fsigmoid(bf_lo(gw.x)); g0[1] = fsigmoid(bf_hi(gw.x)); g0[2] = fsigmoid(bf_lo(gw.y)); g0[3] = fsigmoid(bf_hi(gw.y));
                        g1[0] = fsigmoid(bf_lo(gw.z)); g1[1] = fsigmoid(bf_hi(gw.z)); g1[2] = fsigmoid(bf_lo(gw.w)); g1[3] = fsigmoid(bf_hi(gw.w));
                        const f32x4 v0 = acc[ai][bj][m][0] * g0, v1 = acc[ai][bj][m][1] * g1;
                        u32x4 w; w.x = cvt_pk_bf16(v0[0], v0[1]); w.y = cvt_pk_bf16(v0[2], v0[3]); w.z = cvt_pk_bf16(v1[0], v1[1]); w.w = cvt_pk_bf16(v1[2], v1[3]);
                        *(u32x4*)(M1 + row * 1024 + c) = w; } }
        }
    }
};
struct EpiResid {
    static constexpr bool PERM = true, AFTER_DRAIN = false;
    float* X; const float* modl;
    __device__ __forceinline__ void operator()(const f32x4 (&acc)[2][2][4][2], const Unit& u, int wr, int wc, int fr, int fq) const {
        const int row0 = u.pm * BM + wr * 64 + fr, col0 = u.pn * BM + wc * 32 + 8 * fq;
        const int sel = (u.pm % 33 == 0) ? 4 : (u.pm / 33);
        const float* gt = modl + sel * 6144 + 2048;
#pragma unroll
        for (int bj = 0; bj < 2; ++bj) { const int c = col0 + bj * HALF; const f32x4 t0 = *(const f32x4*)(gt + c), t1 = *(const f32x4*)(gt + c + 4);
#pragma unroll
            for (int ai = 0; ai < 2; ++ai)
#pragma unroll
                for (int m = 0; m < 4; ++m) { float* xp = X + (size_t)(row0 + ai * HALF + m * 16) * 1024 + c;
                    const f32x4 x0 = *(const f32x4*)xp, x1 = *(const f32x4*)(xp + 4);
                    *(f32x4*)xp = x0 + t0 * acc[ai][bj][m][0]; *(f32x4*)(xp + 4) = x1 + t1 * acc[ai][bj][m][1]; } }
    }
};
struct EpiMoeUp {
    static constexpr bool PERM = true, AFTER_DRAIN = false;
    bf16_t* HID; int ldc;
    __device__ __forceinline__ void operator()(const f32x4 (&acc)[2][2][4][2], const Unit& u, int wr, int wc, int fr, int fq) const {
        const int row0 = u.pm * BM + wr * 64 + fr, col0 = u.pn * HALF + wc * 32 + 8 * fq;
#pragma unroll
        for (int ai = 0; ai < 2; ++ai)
#pragma unroll
            for (int m = 0; m < 4; ++m) { bf16_t* rowp = HID + (size_t)(row0 + ai * HALF + m * 16) * ldc + col0;
                f32x4 h0, h1;
#pragma unroll
                for (int i = 0; i < 4; ++i) { const float g0 = acc[ai][0][m][0][i], g1 = acc[ai][0][m][1][i];
                    h0[i] = g0 * fsigmoid(g0) * acc[ai][1][m][0][i]; h1[i] = g1 * fsigmoid(g1) * acc[ai][1][m][1][i]; }
                u32x4 w; w.x = cvt_pk_bf16(h0[0], h0[1]); w.y = cvt_pk_bf16(h0[2], h0[3]); w.z = cvt_pk_bf16(h1[0], h1[1]); w.w = cvt_pk_bf16(h1[2], h1[3]);
                *(u32x4*)rowp = w; }
    }
};
struct EpiMoeDown {
    static constexpr bool PERM = true, AFTER_DRAIN = false;
    bf16_t* YE; const float* gatev;
    __device__ __forceinline__ void operator()(const f32x4 (&acc)[2][2][4][2], const Unit& u, int wr, int wc, int fr, int fq) const {
        const int row0 = u.pm * BM + wr * 64 + fr, col0 = u.pn * BM + wc * 32 + 8 * fq;
#pragma unroll
        for (int ai = 0; ai < 2; ++ai)
#pragma unroll
            for (int m = 0; m < 4; ++m) { const size_t row = (size_t)(row0 + ai * HALF + m * 16); const float gv = gatev[row]; bf16_t* rowp = YE + row * 1024 + col0;
#pragma unroll
                for (int bj = 0; bj < 2; ++bj) { const f32x4 v0 = acc[ai][bj][m][0] * gv, v1 = acc[ai][bj][m][1] * gv;
                    u32x4 w; w.x = cvt_pk_bf16(v0[0], v0[1]); w.y = cvt_pk_bf16(v0[2], v0[3]); w.z = cvt_pk_bf16(v1[0], v1[1]); w.w = cvt_pk_bf16(v1[2], v1[3]);
                    *(u32x4*)(rowp + bj * HALF) = w; } }
    }
};
struct LoraOrder : StaticOrder {
    __host__ __device__ bool next(int i, Unit& u) const { if (!StaticOrder::next(i, u)) return false;
        if (u.pn < 2) { u.k0 = 0; u.nt = 4; } else { u.k0 = 256 + 128 * ((u.pn - 2) >> 1); u.nt = 2; } return true; }
};
struct MergeOrder : StaticOrder {
    __host__ __device__ bool next(int i, Unit& u) const { if (!StaticOrder::next(i >> 1, u)) return false; u.k0 = (i & 1) * 512; u.nt = 8; u.cont = i & 1; return true; }
};
template <bool GATH> struct MoeOrderT {
    static constexpr bool GATHER = GATH; const int* idx;
    __device__ __forceinline__ int arow(int r) const { const int v = idx[r]; return v < 0 ? 0 : v; }
    int nM, nN, nwg, G, c, ntk;
    __host__ __device__ void init(int nM_, int nN_, int G_, int c_, int K_) { ntk = K_ / BK; nM = nM_; nN = nN_; nwg = nM * nN; G = G_; c = c_; }
    __host__ __device__ bool next(int i, Unit& u) const {
        const long L = (long)i * G + c; if (L >= nwg) return false;
        int wgid = (int)L; { const int q = nwg / NXCD, r = nwg % NXCD, xcd = wgid % NXCD, off = wgid / NXCD; wgid = (xcd < r ? xcd * (q + 1) : r * (q + 1) + (xcd - r) * q) + off; }
        const int nig = WGM * nN, gid = wgid / nig, fm = gid * WGM, gsz = (nM - fm) < WGM ? (nM - fm) : WGM;
        u.pm = fm + ((wgid % nig) % gsz); u.pn = (wgid % nig) / gsz;
        const int e = u.pm < 256 ? (u.pm >> 4) : (u.pm - 256); u.pb = e * nN + u.pn; u.k0 = 0; u.nt = ntk; u.cont = 0; return true;
    }
    __device__ __forceinline__ void a_ready(const Unit&) const {}
    __device__ __forceinline__ void done(const Unit&) const {}
};

template <class Epi, class Sched, bool ALIGN_EPI = false, bool SP2 = false>
__device__ __forceinline__ void gemm_phase(PG8_LAS unsigned char* lds, const Gemm g, const Sched& S, const Epi& E) {
    const int tid = ltid(), wid = __builtin_amdgcn_readfirstlane(tid >> 6), lane = tid & 63, wr = wid >> 2, wc = wid & 3, fr = lane & 15, fq = lane >> 4;
    const int lda = g.lda, ldb = g.ldb;
    unsigned voffA[2], voffB[2]; int rowA[2]; unsigned colA[2];
#pragma unroll
    for (int i = 0; i < 2; ++i) { int R, C; stage_rc(tid * 16 + i * 8192, R, C); const int Rb = Epi::PERM ? ((R & ~31) + perm32(R & 31)) : R;
        voffA[i] = (unsigned)(R * lda + C) * 2u; voffB[i] = (unsigned)(Rb * ldb + C) * 2u; rowA[i] = R; colA[i] = (unsigned)C * 2u; }
    const size_t kstep = (size_t)(BK * 2);
    const size_t hstepA = (size_t)HALF * lda * 2, hstepB = (size_t)HALF * ldb * 2;
    const size_t tstepA = 2 * hstepA, tstepB = 2 * hstepB;
    const unsigned ldsw = (unsigned)wid * 1024u;
    const int aoff = lds_byte(wr * 64 + fr, fq * 8), boff = lds_byte(wc * 32 + fr, fq * 8);
#define PG8_SA(b, h) (((b) * 2 + (h)) * HTB)
#define PG8_SB(b, h) ((4 + (b) * 2 + (h)) * HTB)
#define PG8_STAGE(bufoff, gbase, voff) do { _Pragma("unroll") for (int _i = 0; _i < 2; ++_i) \
        __builtin_amdgcn_global_load_lds((const unsigned*)((const char*)(gbase) + (voff)[_i]), (PG8_LAS unsigned*)(lds + (bufoff) + ldsw + _i * 8192), 16, 0, 0); } while (0)
#define PG8_STAGE_SEL(bufoff, gbase, sel, vA, vB) do { _Pragma("unroll") for (int _i = 0; _i < 2; ++_i) \
        __builtin_amdgcn_global_load_lds((const unsigned*)((const char*)(gbase) + ((sel) ? (vA)[_i] : (vB)[_i])), (PG8_LAS unsigned*)(lds + (bufoff) + ldsw + _i * 8192), 16, 0, 0); } while (0)
#define PG8_LDA(dst, b, h) do { _Pragma("unroll") for (int m = 0; m < 4; ++m) _Pragma("unroll") for (int k = 0; k < 2; ++k) dst[m][k] = *(const PG8_LAS bf16x8*)(lds + PG8_SA(b, h) + aoff + m * 2048 + k * 1024); } while (0)
#define PG8_LDB(dst, b, h) do { _Pragma("unroll") for (int n = 0; n < 2; ++n) _Pragma("unroll") for (int k = 0; k < 2; ++k) dst[n][k] = *(const PG8_LAS bf16x8*)(lds + PG8_SB(b, h) + boff + n * 2048 + k * 1024); } while (0)
#define PG8_MMA(ai, bj, At, Bt) do { __builtin_amdgcn_s_setprio(1); _Pragma("unroll") for (int m = 0; m < 4; ++m) _Pragma("unroll") for (int n = 0; n < 2; ++n) _Pragma("unroll") for (int k = 0; k < 2; ++k) \
        acc[ai][bj][m][n] = __builtin_amdgcn_mfma_f32_16x16x32_bf16(Bt[n][k], At[m][k], acc[ai][bj][m][n], 0, 0, 0); __builtin_amdgcn_s_setprio(0); } while (0)
#define PG8_WAIT_V(n) asm volatile("s_waitcnt vmcnt(" #n ")" ::: "memory")
#define PG8_WAIT_L(n) asm volatile("s_waitcnt lgkmcnt(" #n ")" ::: "memory")
#define PG8_BAR __builtin_amdgcn_s_barrier()
#define PG8_SCHED __builtin_amdgcn_sched_barrier(0)
    Unit cur, nxt; int ui = 0;
    if (!S.next(0, cur)) return;
    f32x4 acc[2][2][4][2];
#pragma unroll
    for (int a = 0; a < 2; ++a)
#pragma unroll
        for (int b = 0; b < 2; ++b)
#pragma unroll
            for (int m = 0; m < 4; ++m)
#pragma unroll
                for (int n = 0; n < 2; ++n) acc[a][b][m][n] = (f32x4){0.f, 0.f, 0.f, 0.f};
    bf16x8 At[4][2], B0[2][2], B1[2][2];
    unsigned vc0[2], vc1[2], vn0[2], vn1[2];
#define PG8_SETV(u_, o0, o1) do { _Pragma("unroll") for (int _i = 0; _i < 2; ++_i) { if constexpr (Sched::GATHER) { \
            o0[_i] = (unsigned)S.arow((u_).pm * BM + rowA[_i]) * (unsigned)(lda * 2) + colA[_i]; o1[_i] = (unsigned)S.arow((u_).pm * BM + HALF + rowA[_i]) * (unsigned)(lda * 2) + colA[_i]; } \
        else { o0[_i] = voffA[_i]; o1[_i] = voffA[_i] + (unsigned)hstepA; } } } while (0)
    PG8_SETV(cur, vc0, vc1);
#pragma unroll
    for (int _i = 0; _i < 2; ++_i) { vn0[_i] = vc0[_i]; vn1[_i] = vc1[_i]; }
    const char* cA = (const char*)g.A + (Sched::GATHER ? (size_t)0 : (size_t)cur.pm * tstepA) + (size_t)cur.k0 * 2; const char* cB = (const char*)g.Bt + (size_t)cur.pb * tstepB + (size_t)cur.k0 * 2;
    S.a_ready(cur);
    if constexpr (SP2) {
        PG8_STAGE(PG8_SB(0, 0), cB, voffB); PG8_STAGE(PG8_SB(0, 1), cB + hstepB, voffB); PG8_STAGE(PG8_SA(0, 0), cA, vc0); PG8_STAGE(PG8_SA(0, 1), cA, vc1);
        if (wr == 1) PG8_BAR;
        PG8_WAIT_V(2); PG8_BAR;
        PG8_STAGE(PG8_SB(1, 0), cB + kstep, voffB); PG8_STAGE(PG8_SA(1, 0), cA + kstep, vc0); PG8_STAGE(PG8_SB(1, 1), cB + hstepB + kstep, voffB);
        PG8_WAIT_V(6); PG8_BAR;
    } else {
        PG8_STAGE(PG8_SB(0, 0), cB, voffB); PG8_STAGE(PG8_SA(0, 0), cA, vc0); PG8_STAGE(PG8_SB(0, 1), cB + hstepB, voffB); PG8_STAGE(PG8_SA(0, 1), cA, vc1);
        if (wr == 1) PG8_BAR;
        PG8_WAIT_V(4); PG8_BAR;
        PG8_STAGE(PG8_SB(1, 0), cB + kstep, voffB); PG8_STAGE(PG8_SA(1, 0), cA + kstep, vc0); PG8_STAGE(PG8_SB(1, 1), cB + hstepB + kstep, voffB);
        PG8_WAIT_V(6); PG8_BAR;
    }
    for (;;) {
        const bool has_next = S.next(ui + 1, nxt);
        int rawn0 = 0, rawn1 = 0, rawn2 = 0, rawn3 = 0;
        if constexpr (Sched::GATHER) { if (has_next) {
            const int* ip0 = S.idx + nxt.pm * BM + rowA[0]; const int* ip1 = S.idx + nxt.pm * BM + rowA[1];
            asm volatile("global_load_dword %0, %4, off\n\tglobal_load_dword %1, %5, off\n\tglobal_load_dword %2, %4, off offset:512\n\tglobal_load_dword %3, %5, off offset:512"
                         : "=&v"(rawn0), "=&v"(rawn1), "=&v"(rawn2), "=&v"(rawn3) : "v"(ip0), "v"(ip1) : "memory"); } }
        else { if (has_next) PG8_SETV(nxt, vn0, vn1); }
        const char* nA = has_next ? (const char*)g.A + (Sched::GATHER ? (size_t)0 : (size_t)nxt.pm * tstepA) + (size_t)nxt.k0 * 2 : cA; const char* nB = has_next ? (const char*)g.Bt + (size_t)nxt.pb * tstepB + (size_t)nxt.k0 * 2 : cB;
        const int nt = cur.nt;
        for (int t = 0; t < nt; t += 2) {
            const bool last = (t == nt - 2);
            const char* a1 = cA + (size_t)(t + 1) * kstep;
            const char* a2 = last ? nA : cA + (size_t)(t + 2) * kstep; const char* b2 = last ? nB : cB + (size_t)(t + 2) * kstep;
            const char* a3 = a2 + kstep; const char* b3 = b2 + kstep;
            if (last && has_next) S.a_ready(nxt);
            if constexpr (Sched::GATHER) { if (last && has_next) {
                asm volatile("; gathered row indices of the next unit" : "+v"(rawn0), "+v"(rawn1), "+v"(rawn2), "+v"(rawn3));
                vn0[0] = (unsigned)(rawn0 < 0 ? 0 : rawn0) * (unsigned)(lda * 2) + colA[0]; vn0[1] = (unsigned)(rawn1 < 0 ? 0 : rawn1) * (unsigned)(lda * 2) + colA[1];
                vn1[0] = (unsigned)(rawn2 < 0 ? 0 : rawn2) * (unsigned)(lda * 2) + colA[0]; vn1[1] = (unsigned)(rawn3 < 0 ? 0 : rawn3) * (unsigned)(lda * 2) + colA[1]; } }
            if constexpr (SP2) {
            PG8_LDB(B0, 0, 0); PG8_LDB(B1, 0, 1); PG8_SCHED; PG8_LDA(At, 0, 0); PG8_STAGE(PG8_SA(1, 1), a1, vc1);
            PG8_WAIT_V(8); PG8_WAIT_L(0); PG8_BAR; PG8_MMA(0, 0, At, B0); PG8_MMA(0, 1, At, B1); PG8_BAR; PG8_SCHED;
            PG8_LDA(At, 0, 1); PG8_STAGE(PG8_SB(0, 0), b2, voffB); PG8_STAGE(PG8_SB(0, 1), b2 + hstepB, voffB); PG8_STAGE_SEL(PG8_SA(0, 0), a2, last, vn0, vc0);
            PG8_WAIT_V(8); PG8_WAIT_L(0); PG8_BAR; PG8_MMA(1, 0, At, B0); PG8_MMA(1, 1, At, B1); PG8_BAR; PG8_SCHED;
            PG8_LDB(B0, 1, 0); PG8_LDB(B1, 1, 1); PG8_SCHED; PG8_LDA(At, 1, 0); PG8_STAGE_SEL(PG8_SA(0, 1), a2, last, vn1, vc1);
            PG8_WAIT_V(8); PG8_WAIT_L(0); PG8_BAR; PG8_MMA(0, 0, At, B0); PG8_MMA(0, 1, At, B1); PG8_BAR; PG8_SCHED;
            PG8_LDA(At, 1, 1); PG8_STAGE(PG8_SB(1, 0), b3, voffB); PG8_STAGE(PG8_SB(1, 1), b3 + hstepB, voffB); PG8_STAGE_SEL(PG8_SA(1, 0), a3, last, vn0, vc0);
            PG8_WAIT_V(8); PG8_WAIT_L(0); PG8_BAR; PG8_MMA(1, 0, At, B0); PG8_MMA(1, 1, At, B1); PG8_BAR; PG8_SCHED;
            } else {
            PG8_LDB(B0, 0, 0); PG8_SCHED; PG8_LDA(At, 0, 0); PG8_STAGE(PG8_SA(1, 1), a1, vc1);
            PG8_WAIT_L(8); PG8_BAR; PG8_WAIT_L(0); PG8_MMA(0, 0, At, B0); PG8_BAR; PG8_SCHED;
            PG8_LDB(B1, 0, 1); PG8_STAGE(PG8_SB(0, 0), b2, voffB);
            PG8_BAR; PG8_WAIT_L(0); PG8_MMA(0, 1, At, B1); PG8_BAR;
            PG8_LDA(At, 0, 1); PG8_STAGE_SEL(PG8_SA(0, 0), a2, last, vn0, vc0);
            PG8_BAR; PG8_WAIT_L(0); PG8_MMA(1, 0, At, B0); PG8_BAR; PG8_SCHED;
            PG8_STAGE(PG8_SB(0, 1), b2 + hstepB, voffB);
            PG8_WAIT_V(6); PG8_BAR; PG8_MMA(1, 1, At, B1); PG8_BAR;
            PG8_LDB(B0, 1, 0); PG8_SCHED; PG8_LDA(At, 1, 0); PG8_STAGE_SEL(PG8_SA(0, 1), a2, last, vn1, vc1);
            PG8_WAIT_L(8); PG8_BAR; PG8_WAIT_L(0); PG8_MMA(0, 0, At, B0); PG8_BAR; PG8_SCHED;
            PG8_LDB(B1, 1, 1); PG8_STAGE(PG8_SB(1, 0), b3, voffB);
            PG8_BAR; PG8_WAIT_L(0); PG8_MMA(0, 1, At, B1); PG8_BAR;
            PG8_LDA(At, 1, 1); PG8_STAGE_SEL(PG8_SA(1, 0), a3, last, vn0, vc0);
            PG8_BAR; PG8_WAIT_L(0); PG8_MMA(1, 0, At, B0); PG8_BAR; PG8_SCHED;
            PG8_STAGE(PG8_SB(1, 1), b3 + hstepB, voffB);
            PG8_WAIT_V(6); PG8_BAR; PG8_MMA(1, 1, At, B1); PG8_BAR;
            }
        }
        if constexpr (ALIGN_EPI) { if (wr == 0) PG8_BAR; }
        if constexpr (!Epi::AFTER_DRAIN) { E(acc, cur, wr, wc, fr, fq); S.done(cur); }
        if (!has_next) break;
        if (!nxt.cont)
#pragma unroll
        for (int a = 0; a < 2; ++a)
#pragma unroll
            for (int b = 0; b < 2; ++b)
#pragma unroll
                for (int m = 0; m < 4; ++m)
#pragma unroll
                    for (int n = 0; n < 2; ++n) acc[a][b][m][n] = (f32x4){0.f, 0.f, 0.f, 0.f};
        cur = nxt; cA = nA; cB = nB; ++ui;
#pragma unroll
        for (int _i = 0; _i < 2; ++_i) { vc0[_i] = vn0[_i]; vc1[_i] = vn1[_i]; }
        if constexpr (ALIGN_EPI) { if (wr == 1) PG8_BAR; }
    }
    PG8_WAIT_V(0);
    if constexpr (!ALIGN_EPI) { if (wr == 0) PG8_BAR; }
    PG8_BAR;
    if constexpr (Epi::AFTER_DRAIN) { E.fused(acc, cur, wr, wc, fr, fq, lds, wid, lane); S.done(cur); }
#undef PG8_SETV
#undef PG8_SA
#undef PG8_SB
#undef PG8_STAGE
#undef PG8_STAGE_SEL
#undef PG8_LDA
#undef PG8_LDB
#undef PG8_MMA
#undef PG8_WAIT_V
#undef PG8_WAIT_L
#undef PG8_BAR
#undef PG8_SCHED
}
}

namespace attn_body {
using bf16=__hip_bfloat16;
using bf16x8=__attribute__((ext_vector_type(8)))short;
using s16x4=__attribute__((ext_vector_type(4)))short;
using f32x16=__attribute__((ext_vector_type(16)))float;
using u32x4=__attribute__((ext_vector_type(4)))unsigned;
constexpr int D=64,QP=512,KP=128,OP=1024;
constexpr int NW=8,QBLK=32,QB=QBLK*NW,KVBLK=64;
constexpr int ATTN_UNIT_ROWS=QB;
__device__ __forceinline__ int crow(int r,int hi){return (r&3)+8*(r>>2)+4*hi;}
#define SBAR() __builtin_amdgcn_sched_barrier(0)
constexpr int NSLOT=3, SLOTB=8192;
constexpr int LDS_K=0, LDS_V=NSLOT*SLOTB, LDS_WS=2*NSLOT*SLOTB, LDS_OST=LDS_WS+NW*64*4, LDS_BYTES=LDS_OST+NW*4096;
constexpr float C2=0.125f*1.4426950408889634f;
__device__ __forceinline__ void glds16(const void*gsrc,unsigned lds_dst){unsigned keep;
  asm volatile("s_mov_b32 %0, m0\n\ts_mov_b32 m0, %2\n\ts_nop 0\n\tglobal_load_lds_dwordx4 %1, off\n\ts_mov_b32 m0, %0":"=&s"(keep):"v"(gsrc),"s"(lds_dst):"memory");}
__device__ __forceinline__ float max3f(float a,float b,float c){float r;asm("v_max3_f32 %0, %1, %2, %3":"=v"(r):"v"(a),"v"(b),"v"(c));return r;}
__device__ __forceinline__ float max2f(float a,float b){float r;asm("v_max_f32_e32 %0, %1, %2":"=v"(r):"v"(a),"v"(b));return r;}
__device__ __forceinline__ float fadd_s(float a,float b){float r;asm("v_add_f32_e32 %0, %1, %2":"=v"(r):"v"(a),"v"(b));return r;}
__device__ __forceinline__ float fsub_s(float a,float b){float r;asm("v_sub_f32_e32 %0, %1, %2":"=v"(r):"v"(a),"v"(b));return r;}
typedef float f32x2_t __attribute__((ext_vector_type(2))); typedef __bf16 bf16x2_t __attribute__((ext_vector_type(2)));
__device__ __forceinline__ unsigned cvtpk_s(float lo,float hi){f32x2_t v={lo,hi};bf16x2_t b=__builtin_convertvector(v,bf16x2_t);return __builtin_bit_cast(unsigned,b);}
#define WAIT_BAR(N) asm volatile("s_waitcnt vmcnt(" #N ") lgkmcnt(0)\n\ts_barrier":::"memory")

__device__ __forceinline__ void qkt(f32x16&p0,f32x16&p1,const char*Kslot,const bf16x8*qr,const f32x16&negm,int r32,int hi){
  const char*kb=Kslot+hi*1024+r32*16;
  #pragma unroll
  for(int d0=0;d0<4;++d0){
    const bf16x8 b0=*reinterpret_cast<const bf16x8*>(kb+d0*2048);
    const bf16x8 b1=*reinterpret_cast<const bf16x8*>(kb+d0*2048+512);
    if(d0==0){p0=__builtin_amdgcn_mfma_f32_32x32x16_bf16(b0,qr[0],negm,0,0,0);p1=__builtin_amdgcn_mfma_f32_32x32x16_bf16(b1,qr[0],negm,0,0,0);}
    else{p0=__builtin_amdgcn_mfma_f32_32x32x16_bf16(b0,qr[d0],p0,0,0,0);p1=__builtin_amdgcn_mfma_f32_32x32x16_bf16(b1,qr[d0],p1,0,0,0);}}
}
typedef __attribute__((address_space(3))) const char* lds_cptr;
typedef short v4i16_t __attribute__((ext_vector_type(4)));
__device__ __forceinline__ void kload8(bf16x8*kf,lds_cptr kp){
  kf[0]=*(const __attribute__((address_space(3))) bf16x8*)(kp);      kf[1]=*(const __attribute__((address_space(3))) bf16x8*)(kp+512);
  kf[2]=*(const __attribute__((address_space(3))) bf16x8*)(kp+2048); kf[3]=*(const __attribute__((address_space(3))) bf16x8*)(kp+2560);
  kf[4]=*(const __attribute__((address_space(3))) bf16x8*)(kp+4096); kf[5]=*(const __attribute__((address_space(3))) bf16x8*)(kp+4608);
  kf[6]=*(const __attribute__((address_space(3))) bf16x8*)(kp+6144); kf[7]=*(const __attribute__((address_space(3))) bf16x8*)(kp+6656);
}
__device__ __forceinline__ void kload2(bf16x8*kf,lds_cptr kp,int j){ kf[2*j]=*(const __attribute__((address_space(3))) bf16x8*)(kp+j*2048); kf[2*j+1]=*(const __attribute__((address_space(3))) bf16x8*)(kp+j*2048+512); }
__device__ __forceinline__ s16x4 vtr(lds_cptr p){ return __builtin_bit_cast(s16x4,__builtin_amdgcn_ds_read_tr16_b64_v4i16((__attribute__((address_space(3))) v4i16_t*)p)); }
__device__ __forceinline__ float rowmax(const f32x16&p0,const f32x16&p1){
  float a=max3f(p0[0],p0[1],p1[0]),b=max3f(p0[2],p0[3],p1[1]);a=max3f(a,p1[2],p1[3]);
  #pragma unroll
  for(int r=4;r<16;r+=4){a=max3f(a,p0[r],p0[r+1]);b=max3f(b,p0[r+2],p0[r+3]);a=max3f(a,p1[r],p1[r+1]);b=max3f(b,p1[r+2],p1[r+3]);}
  const float m=max2f(a,b);
  auto rr=__builtin_amdgcn_permlane32_swap(__float_as_uint(m),__float_as_uint(m),false,false);
  return max2f(__uint_as_float(rr[0]),__uint_as_float(rr[1]));
}
__device__ __forceinline__ void pv(f32x16*o,int vb,bf16x8 pa0,bf16x8 pa1,bf16x8 pa2,bf16x8 pa3){
  #pragma unroll
  for(int d0=0;d0<2;++d0){s16x4 lo[4],hi[4];
    #pragma unroll
    for(int ks=0;ks<4;++ks){
      asm volatile("ds_read_b64_tr_b16 %0,%1 offset:%c2":"=&v"(lo[ks]):"v"(vb),"i"(d0*4096+ks*1024):"memory");
      asm volatile("ds_read_b64_tr_b16 %0,%1 offset:%c2":"=&v"(hi[ks]):"v"(vb),"i"(d0*4096+ks*1024+512):"memory");}
    asm volatile("s_waitcnt lgkmcnt(0)":::"memory");SBAR();
    #define PK(k) (bf16x8){lo[k][0],lo[k][1],lo[k][2],lo[k][3],hi[k][0],hi[k][1],hi[k][2],hi[k][3]}
    o[d0]=__builtin_amdgcn_mfma_f32_32x32x16_bf16(pa0,PK(0),o[d0],0,0,0);
    o[d0]=__builtin_amdgcn_mfma_f32_32x32x16_bf16(pa1,PK(1),o[d0],0,0,0);
    o[d0]=__builtin_amdgcn_mfma_f32_32x32x16_bf16(pa2,PK(2),o[d0],0,0,0);
    o[d0]=__builtin_amdgcn_mfma_f32_32x32x16_bf16(pa3,PK(3),o[d0],0,0,0);
    #undef PK
  }
}

#ifndef ATTN_STORE16
#define ATTN_STORE16(p,v) (*(u32x4*)(p)=(v))
#endif
template<int THRL> __device__ __forceinline__ void attn_unit(long qrow0,int h,long krow0,int NT,const bf16*Q,const bf16*__restrict__ K,const bf16*__restrict__ V,bf16*O,char*shm){
  const int tid=ltid(),lane=tid&63,r32=lane&31,hi=lane>>5; const int wid=__builtin_amdgcn_readfirstlane(tid>>6);
  const bf16*Qw=Q+(qrow0+wid*QBLK)*QP+h*D;
  const bf16*Kh=K+krow0*KP+(h>>2)*D,*Vh=V+krow0*KP+(h>>2)*D;
  const unsigned lds0=(unsigned)(uintptr_t)shm;
  float*wsf=(float*)(shm+LDS_WS)+wid*64;
  const bf16*ksrc=Kh+(long)lane*KP+wid*8;
  const bf16*vsrc=Vh+(long)(16*(wid&3)+(lane>>2))*KP+(wid>>2)*32+(lane&3)*8;
  const unsigned kdst=lds0+LDS_K+wid*1024, vdst=lds0+LDS_V+wid*1024;
  #define DMA_K(t,slot) glds16(ksrc+(long)(t)*KVBLK*KP,(unsigned)__builtin_amdgcn_readfirstlane(kdst+(slot)))
  #define DMA_V(t,slot) glds16(vsrc+(long)(t)*KVBLK*KP,(unsigned)__builtin_amdgcn_readfirstlane(vdst+(slot)))
  const int vb0=(int)(lds0+LDS_V)+((lane>>4)&1)*32+(lane&3)*8+(4*hi+((lane&15)>>2))*64;
  const char*Kbase=shm+LDS_K; bf16x8 kf[8];
  const lds_cptr shm3=(lds_cptr)shm; const lds_cptr kp0=shm3+LDS_K+hi*1024+r32*16; const lds_cptr vp0=shm3+LDS_V+((lane>>4)&1)*32+(lane&3)*8+(4*hi+((lane&15)>>2))*64;
  DMA_K(0,0);DMA_V(0,0);DMA_K(1,SLOTB);
  bf16x8 qr[4];
  #pragma unroll
  for(int d0=0;d0<4;++d0)qr[d0]=*reinterpret_cast<const bf16x8*>(&Qw[(long)r32*QP+d0*16+hi*8]);
  float mhat=0.f,l_reg=0.f;f32x16 o[2];o[0]=f32x16{};o[1]=f32x16{};f32x16 negm=f32x16{};asm volatile("":"+v"(negm));
  #define CMASK(P0,P1,t) do{}while(0)
  bool resc=false;
  #define START(P0,P1) do{ const float rm=rowmax(P0,P1); resc=false; \
    { const float dl=rm; mhat=fadd_s(mhat,dl); \
      _Pragma("unroll") for(int r=0;r<16;++r){P0[r]=fsub_s(P0[r],dl);P1[r]=fsub_s(P1[r],dl);} \
      _Pragma("unroll") for(int r=0;r<16;++r)negm[r]=-mhat; asm volatile("":"+v"(negm)); } \
    _Pragma("unroll") for(int r=0;r<16;++r)P0[r]=__builtin_amdgcn_exp2f(P0[r]); }while(0)
  #define RESC() do{ if(resc){ asm volatile("s_waitcnt lgkmcnt(0)":::"memory"); \
      _Pragma("unroll") for(int d_=0;d_<2;++d_) _Pragma("unroll") for(int r=0;r<16;++r)o[d_][r]*=wsf[crow(r,hi)]; } }while(0)
  f32x16 pA0,pA1,pB0,pB1;
  int sl_prev=0,sl_cur=0,sl_next=SLOTB;
  #define ROT() do{sl_prev=sl_cur;sl_cur=sl_next;sl_next=(sl_next==(NSLOT-1)*SLOTB)?0:sl_next+SLOTB;}while(0)
  DMA_K(2,2*SLOTB);
  WAIT_BAR(3);
  qkt(pA0,pA1,Kbase,qr,negm,r32,hi);asm volatile("s_nop 15\n\ts_nop 7":"+v"(pA0),"+v"(pA1));CMASK(pA0,pA1,0);
  START(pA0,pA1);
  _Pragma("unroll") for(int r=0;r<16;++r)pA1[r]=__builtin_amdgcn_exp2f(pA1[r]);
  WAIT_BAR(0);
  DMA_K(3,0);DMA_V(1,SLOTB);
  ROT();
  kload8(kf,kp0+sl_cur);
  WAIT_BAR(2);
  s16x4 vlo[8],vhi[8]; u32x4 pw0,pw1,pw2,pw3;
  #define PKW(P,B) cvtpk_s(P[B],P[B+1])
  #define PAF(k) __builtin_bit_cast(bf16x8,pw##k)
  #define VFR(i) (bf16x8){vlo[i][0],vlo[i][1],vlo[i][2],vlo[i][3],vhi[i][0],vhi[i][1],vhi[i][2],vhi[i][3]}
  #define PIN(x) asm volatile("":"+v"(x))
  #define MX3(a,b,c) __builtin_fmaxf(__builtin_fmaxf((a),(b)),(c))
  #define GAPA(MF,A0,A1,A2,A3,W0,W1,PW) do{ MF; sacc+=A0; sacc+=A1; sacc+=A2; sacc+=A3; PIN(sacc); W0; W1; PIN(PW); SBAR(); }while(0)
  #define EX(v) __builtin_amdgcn_exp2f(v)
  #define GAPB(MF,X,B) do{ MF; X[B]=EX(X[B]); X[B+1]=EX(X[B+1]); X[B+2]=EX(X[B+2]); X[B+3]=EX(X[B+3]); PIN(X); SBAR(); }while(0)
  #define VRD(i) do{ vlo[i]=vtr(vp_+(((i)>>2)*4096+((i)&3)*1024)); vhi[i]=vtr(vp_+(((i)>>2)*4096+((i)&3)*1024+512)); }while(0)
  #define KRD(G,j) do{ if(G){ kload2(kf,kp0+sl_next,j); SBAR(); } }while(0)
  #define STEP(C0,C1,P0,P1,t,GK,GV,GL) do{ SBAR(); \
    const lds_cptr vp_=vp0+sl_prev; \
    VRD(0); SBAR(); float sacc=(P0[0]+P0[1]); \
    GAPA(C0=__builtin_amdgcn_mfma_f32_32x32x16_bf16(kf[0],qr[0],negm,0,0,0), P0[2],P0[3],P0[4],P0[5],     pw0[0]=PKW(P0,0), pw0[1]=PKW(P0,2), pw0); \
    VRD(4); SBAR(); GAPA(C1=__builtin_amdgcn_mfma_f32_32x32x16_bf16(kf[1],qr[0],negm,0,0,0), P0[6],P0[7],P0[8],P0[9],     pw0[2]=PKW(P0,4), pw0[3]=PKW(P0,6), pw0); \
    VRD(1); SBAR(); GAPA(C0=__builtin_amdgcn_mfma_f32_32x32x16_bf16(kf[2],qr[1],C0,0,0,0),   P0[10],P0[11],P0[12],P0[13], pw1[0]=PKW(P0,8), pw1[1]=PKW(P0,10), pw1); \
    VRD(5); SBAR(); GAPA(C1=__builtin_amdgcn_mfma_f32_32x32x16_bf16(kf[3],qr[1],C1,0,0,0),   P0[14],P0[15],P1[0],P1[1],   pw1[2]=PKW(P0,12),pw1[3]=PKW(P0,14), pw1); \
    VRD(2); SBAR(); GAPA(C0=__builtin_amdgcn_mfma_f32_32x32x16_bf16(kf[4],qr[2],C0,0,0,0),   P1[2],P1[3],P1[4],P1[5],     pw2[0]=PKW(P1,0), pw2[1]=PKW(P1,2), pw2); \
    VRD(6); SBAR(); GAPA(C1=__builtin_amdgcn_mfma_f32_32x32x16_bf16(kf[5],qr[2],C1,0,0,0),   P1[6],P1[7],P1[8],P1[9],     pw2[2]=PKW(P1,4), pw2[3]=PKW(P1,6), pw2); \
    VRD(3); SBAR(); GAPA(C0=__builtin_amdgcn_mfma_f32_32x32x16_bf16(kf[6],qr[3],C0,0,0,0),   P1[10],P1[11],P1[12],P1[13], pw3[0]=PKW(P1,8), pw3[1]=PKW(P1,10), pw3); \
    VRD(7); SBAR(); GAPA(C1=__builtin_amdgcn_mfma_f32_32x32x16_bf16(kf[7],qr[3],C1,0,0,0),   P1[14],P1[15],0.f,0.f,       pw3[2]=PKW(P1,12),pw3[3]=PKW(P1,14), pw3); \
    l_reg+=sacc; \
    if(GK){DMA_K((t)+3,sl_cur);} if(GV){DMA_V((t)+1,sl_next);} \
    CMASK(C0,C1,t); \
    { float a=MX3(C0[0],C0[1],C1[0]),b=MX3(C0[2],C0[3],C1[1]); a=MX3(a,C1[2],C1[3]); \
      _Pragma("unroll") for(int r=4;r<16;r+=4){a=MX3(a,C0[r],C0[r+1]);b=MX3(b,C0[r+2],C0[r+3]);a=MX3(a,C1[r],C1[r+1]);b=MX3(b,C1[r+2],C1[r+3]);} \
      float rm=__builtin_fmaxf(a,b); { auto rr=__builtin_amdgcn_permlane32_swap(__float_as_uint(rm),__float_as_uint(rm),false,false); rm=__builtin_fmaxf(__uint_as_float(rr[0]),__uint_as_float(rr[1])); } \
      resc=false; \
      if(__builtin_expect(__any(rm>(float)THRL),0)){ const float dl=__builtin_fmaxf(rm,0.f); mhat+=dl; \
        _Pragma("unroll") for(int r=0;r<16;++r){C0[r]-=dl;C1[r]-=dl;} \
        _Pragma("unroll") for(int r=0;r<16;++r)negm[r]=-mhat; asm volatile("":"+v"(negm)); \
        const float f=__builtin_amdgcn_exp2f(-dl); l_reg*=f; if(hi==0)wsf[r32]=f; resc=true; } } \
    SBAR(); \
    GAPB(o[0]=__builtin_amdgcn_mfma_f32_32x32x16_bf16(PAF(0),VFR(0),o[0],0,0,0), C0,0); \
    GAPB(o[1]=__builtin_amdgcn_mfma_f32_32x32x16_bf16(PAF(0),VFR(4),o[1],0,0,0), C0,4); \
    KRD(GL,0); GAPB(o[0]=__builtin_amdgcn_mfma_f32_32x32x16_bf16(PAF(1),VFR(1),o[0],0,0,0), C0,8); \
    KRD(GL,1); GAPB(o[1]=__builtin_amdgcn_mfma_f32_32x32x16_bf16(PAF(1),VFR(5),o[1],0,0,0), C0,12); \
    KRD(GL,2); GAPB(o[0]=__builtin_amdgcn_mfma_f32_32x32x16_bf16(PAF(2),VFR(2),o[0],0,0,0), C1,0); \
    KRD(GL,3); GAPB(o[1]=__builtin_amdgcn_mfma_f32_32x32x16_bf16(PAF(2),VFR(6),o[1],0,0,0), C1,4); \
    GAPB(o[0]=__builtin_amdgcn_mfma_f32_32x32x16_bf16(PAF(3),VFR(3),o[0],0,0,0), C1,8); \
    GAPB(o[1]=__builtin_amdgcn_mfma_f32_32x32x16_bf16(PAF(3),VFR(7),o[1],0,0,0), C1,12); \
    }while(0)
  int t=1;
  #undef CMASK
  #define CMASK(P0,P1,t) do{}while(0)
  for(;t+5<NT;t+=2){
    STEP(pB0,pB1,pA0,pA1,t,true,true,true);     WAIT_BAR(2); RESC(); ROT();
    STEP(pA0,pA1,pB0,pB1,t+1,true,true,true);   WAIT_BAR(2); RESC(); ROT();
  }
  #undef CMASK
  #define CMASK(P0,P1,t) do{}while(0)
  #define ENDW(tt) do{ if((tt)+3<NT){WAIT_BAR(2);} else if((tt)+2<NT){WAIT_BAR(1);} else {WAIT_BAR(0);} }while(0)
  for(;t+1<NT;t+=2){
    STEP(pB0,pB1,pA0,pA1,t,(t+3<NT),(t+1<NT),(t+1<NT));       ENDW(t);   RESC(); ROT();
    STEP(pA0,pA1,pB0,pB1,t+1,(t+4<NT),(t+2<NT),(t+2<NT));     ENDW(t+1); RESC(); ROT();
  }
  STEP(pB0,pB1,pA0,pA1,NT-1,false,false,false); RESC();
  { float sacc=pB0[0]+pB0[1]; _Pragma("unroll") for(int r=2;r<16;++r)sacc+=pB0[r]; _Pragma("unroll") for(int r=0;r<16;++r)sacc+=pB1[r]; l_reg+=sacc;
    pw0=(u32x4){PKW(pB0,0),PKW(pB0,2),PKW(pB0,4),PKW(pB0,6)};pw1=(u32x4){PKW(pB0,8),PKW(pB0,10),PKW(pB0,12),PKW(pB0,14)};pw2=(u32x4){PKW(pB1,0),PKW(pB1,2),PKW(pB1,4),PKW(pB1,6)};pw3=(u32x4){PKW(pB1,8),PKW(pB1,10),PKW(pB1,12),PKW(pB1,14)};
    SBAR(); pv(o,vb0+sl_cur,PAF(0),PAF(1),PAF(2),PAF(3)); }
  #undef PKW
  #undef PAF
  #undef VFR
  #undef PIN
  #undef MX3
  #undef GAPA
  #undef GAPB
  #undef EX
  #undef VRD
  #undef KRD
  #undef STEP
  #undef ENDW
  {auto rr=__builtin_amdgcn_permlane32_swap(__float_as_uint(l_reg),__float_as_uint(l_reg),false,false);l_reg=__uint_as_float(rr[0])+__uint_as_float(rr[1]);}
  if(hi==0)wsf[32+r32]=l_reg;asm volatile("s_waitcnt lgkmcnt(0)":::"memory");
  float rli[16];
  #pragma unroll
  for(int r=0;r<16;++r)rli[r]=__builtin_amdgcn_rcpf(wsf[32+crow(r,hi)]);
  bf16*Ow=O+(qrow0+wid*QBLK)*OP+h*D;
  { bf16*stg=(bf16*)(shm+LDS_OST)+wid*2048;
    #pragma unroll
    for(int r=0;r<16;++r){const int orow=crow(r,hi);
      #pragma unroll
      for(int d0=0;d0<2;++d0)stg[orow*64+d0*32+r32]=__float2bfloat16(o[d0][r]*rli[r]);}
    asm volatile("s_waitcnt lgkmcnt(0)":::"memory");
    #pragma unroll
    for(int i=0;i<4;++i){const int row=i*8+(lane>>3),ch=lane&7; const u32x4 v=*(const u32x4*)(stg+row*64+ch*8); ATTN_STORE16(Ow+(long)row*OP+ch*8,v);} }
  asm volatile("s_waitcnt lgkmcnt(0)\n\ts_barrier":::"memory");
  #undef DMA_K
  #undef DMA_V
  #undef CMASK
  #undef START
  #undef RESC
  #undef ROT
}
constexpr int ATTN_LDS_BYTES=LDS_BYTES;
#undef SBAR
#undef WAIT_BAR
}

constexpr int NWAVES = 8;
constexpr int NB = 4, TL = 8192, TCX = 256, TP = TL + TCX  , MR = NB * TP  , DM = 1024, NLAYER = 2;
constexpr int RW = 512, NE = 16, FF = 2816;
constexpr int UC = 4864;
constexpr int U_R = 0, U_K = 512, U_V = 1024, U_GLO = 1536, U_DLO = 1696, U_ALO = 1824, RWKV_COLS = 1952, U_Q = 1952, U_KQ = 2464, U_VQ = 2592, U_GR = 2720, U_GA = 3744, IN_COLS = 4768;
constexpr int LK = 768;
constexpr int LOC = 2560;
constexpr int CAP_L = 1024, CAP_C = 32;
constexpr int SLOT_L = NE * NB * CAP_L  , SLOT_ALL = SLOT_L + NE * 256  ;
constexpr float NORM_EPS = 1e-6f, GN_EPS = 64e-5f;
constexpr float QSCALE = 0.125f * 1.4426950408889634f;

constexpr size_t al256(size_t x) { return (x + 255) & ~(size_t)255; }
constexpr size_t WS_CTL = 0, CTL_ZERO_BYTES = 1u << 20;
constexpr size_t WS_MODV = CTL_ZERO_BYTES;
constexpr size_t WS_ROPE = WS_MODV + al256((size_t)2 * 5 * 6144 * 4);
constexpr size_t WS_WIN = WS_ROPE + (size_t)TL * 32 * 8;
constexpr size_t WS_WLORA = WS_WIN + (size_t)2 * UC * DM * 2;
constexpr size_t WS_WBR = WS_WLORA + (size_t)2 * LOC * LK * 2;
constexpr size_t WS_WBA = WS_WBR + (size_t)2 * DM * 512 * 2;
constexpr size_t WS_WOUT = WS_WBA + (size_t)2 * DM * 512 * 2;
constexpr size_t WS_WGU = WS_WOUT + (size_t)2 * DM * DM * 2;
constexpr size_t WS_WD = WS_WGU + (size_t)NE * 2 * FF * DM * 2;
constexpr size_t WS_X = WS_WD + (size_t)NE * DM * FF * 2;
constexpr size_t WS_H = WS_X + (size_t)MR * DM * 4;
constexpr size_t WS_AFF = WS_H + (size_t)MR * DM * 2;
constexpr size_t WS_TOKMAP = WS_AFF + (size_t)MR * 16 * 4;
constexpr size_t WS_IDX = WS_TOKMAP + (size_t)MR * 16 * 4;
constexpr size_t WS_GATEV = WS_IDX + al256((size_t)SLOT_ALL * 4);
constexpr size_t WS_BIG = WS_GATEV + al256((size_t)SLOT_ALL * 4);
constexpr size_t WS_U = WS_BIG;
constexpr size_t WS_RKV = WS_U + (size_t)MR * UC * 2;
constexpr size_t WS_L = WS_RKV + (size_t)MR * 1536 * 2;
constexpr size_t WS_LO = WS_L + (size_t)MR * LK * 2;
constexpr size_t WS_Q = WS_LO + (size_t)MR * LOC * 2;
constexpr size_t WS_KB = WS_Q + (size_t)MR * 512 * 2;
constexpr size_t WS_VB = WS_KB + (size_t)MR * 128 * 2;
constexpr size_t WS_Y = WS_VB + (size_t)MR * 128 * 2;
constexpr size_t WS_YO = WS_Y + (size_t)2 * MR * 512 * 2;
constexpr size_t WS_MIX_END = WS_YO + (size_t)MR * 1024 * 2;
constexpr size_t WS_M1 = WS_RKV;
static_assert(WS_M1 + (size_t)MR * DM * 2 <= WS_Q, "M1 overlay");
constexpr size_t WS_XE = WS_BIG;
constexpr size_t WS_HID = WS_XE + (size_t)SLOT_ALL * DM * 2;
constexpr size_t WS_MOE_END = WS_HID + (size_t)SLOT_ALL * FF * 2;
constexpr size_t WS_END = WS_MIX_END > WS_MOE_END ? WS_MIX_END : WS_MOE_END;
constexpr int CW_TMO = 0, CW_CODE = 1, CW_BAR = 4096;

constexpr int RING_OFF = 0, RING_BYTES = 131072;
constexpr int LDSCTL_OFF = RING_BYTES, MISC_OFF = LDSCTL_OFF + 320;
constexpr int LDS_BYTES = 147456;

#define GAS __attribute__((address_space(1)))
#define LAS __attribute__((address_space(3)))
typedef unsigned short bf16;
typedef unsigned v4u __attribute__((ext_vector_type(4)));
typedef unsigned v2u __attribute__((ext_vector_type(2)));
typedef float f32x4 __attribute__((ext_vector_type(4)));
typedef GAS unsigned gu32;
#define RLX_AGENT __ATOMIC_RELAXED, __HIP_MEMORY_SCOPE_AGENT
#define LDS_WAIT() asm volatile("s_waitcnt lgkmcnt(0)" ::: "memory")
#define VM_WAIT() asm volatile("s_waitcnt vmcnt(0)" ::: "memory")
__device__ __forceinline__ unsigned f2bf(float f) { unsigned u = __builtin_bit_cast(unsigned, f); return (u + 0x7fffu + ((u >> 16) & 1u)) >> 16; }
__device__ __forceinline__ unsigned pk2(float lo, float hi) { return f2bf(lo) | (f2bf(hi) << 16); }
__device__ __forceinline__ float bflo(unsigned u) { return __uint_as_float(u << 16); }
__device__ __forceinline__ float bfhi(unsigned u) { return __uint_as_float(u & 0xffff0000u); }
__device__ __forceinline__ float bf1(bf16 u) { return __uint_as_float((unsigned)u << 16); }
__device__ __forceinline__ float sigm(float x) { return 1.0f / (1.0f + __expf(-x)); }

#define XB_TMO      128
#define XB_XCNT(j)  (256  + 64 * (j))
#define XB_XSUB(j)  (1280 + 64 * (j))
#define XB_XGEN(j)  (2304 + 64 * (j))
#define XB_TOP      3328
#define XB_TOPGEN   3392
#define XCD_BAR_WORDS 3456
#define XB_SPIN_CAP (1u << 18)

__device__ __forceinline__ unsigned xb_ld(unsigned* p)              { return __hip_atomic_load(p, __ATOMIC_RELAXED, __HIP_MEMORY_SCOPE_AGENT); }
__device__ __forceinline__ unsigned xb_add(unsigned* p, unsigned v) { return __hip_atomic_fetch_add(p, v, __ATOMIC_RELAXED, __HIP_MEMORY_SCOPE_AGENT); }
__device__ __forceinline__ unsigned xb_xcc_id() { return (unsigned)__builtin_amdgcn_s_getreg((3 << 11) | 20) & 0xFu; }
#define XB_SPIN(cond, bar) do { unsigned _sp = 0; while (cond) { __builtin_amdgcn_s_sleep(1); \
    if ((++_sp & 255u) == 0u) { if (xb_ld(&(bar)[XB_TMO])) break; if (_sp > XB_SPIN_CAP) { atomicAdd(&(bar)[XB_TMO], 1u); break; } } } } while (0)

struct XcdBarrier {
    unsigned* bar; unsigned x;
    volatile LAS unsigned* st;
};

__device__ __forceinline__ XcdBarrier xcd_barrier_post(unsigned* bar, volatile LAS unsigned* st) {
    XcdBarrier b; b.bar = bar; b.x = xb_xcc_id(); b.st = st;
    if (threadIdx.x == 0) (void)xb_add(&bar[XB_XCNT(b.x)], 1u);
    return b;
}
__device__ __forceinline__ void xcd_barrier_complete(unsigned* bar, unsigned x, unsigned& nloc, unsigned& nx) {
    const unsigned G = gridDim.x * gridDim.y * gridDim.z;
    unsigned sum, cnt, mine, sp = 0u;
    for (;;) {
        sum = 0u; cnt = 0u; mine = 0u;
#pragma unroll
        for (unsigned j = 0; j < 16; ++j) { const unsigned c = xb_ld(&bar[XB_XCNT(j)]); sum += c; cnt += (c > 0u) ? 1u : 0u; mine = (j == x) ? c : mine; }
        if (sum == G) break;
        __builtin_amdgcn_s_sleep(1);
        if ((++sp & 255u) == 0u) { if (xb_ld(&bar[XB_TMO])) break; if (sp > XB_SPIN_CAP) { atomicAdd(&bar[XB_TMO], 1u); break; } }
    }
    nloc = mine > 0u ? mine : 1u; nx = cnt > 0u ? cnt : 1u;
}

__device__ __forceinline__ void xcd_barrier(const XcdBarrier& b) {
    asm volatile("s_waitcnt vmcnt(0)" ::: "memory");
    __syncthreads();
    if (threadIdx.x == 0) {
        unsigned* bar = b.bar;
        __builtin_amdgcn_s_waitcnt(0);
        unsigned nloc = b.st[0], nx = b.st[1];
        if (nloc == 0u) { xcd_barrier_complete(bar, b.x, nloc, nx); b.st[0] = nloc; b.st[1] = nx; }
        const unsigned old = xb_add(&bar[XB_XSUB(b.x)], 1u);
        const unsigned gen = old / nloc;
        if (old + 1u == (gen + 1u) * nloc) {
            __builtin_amdgcn_fence(__ATOMIC_RELEASE, "agent");
            asm volatile("s_waitcnt vmcnt(0)" ::: "memory");
            const unsigned og = xb_add(&bar[XB_TOP], 1u);
            const unsigned tg = og / nx;
            if (og + 1u == (tg + 1u) * nx) xb_add(&bar[XB_TOPGEN], 1u);
            else XB_SPIN(xb_ld(&bar[XB_TOPGEN]) == tg, bar);
            __builtin_amdgcn_fence(__ATOMIC_ACQUIRE, "agent");
            xb_add(&bar[XB_XGEN(b.x)], 1u);
            asm volatile("s_waitcnt vmcnt(0)" ::: "memory");
        } else {
            XB_SPIN(xb_ld(&bar[XB_XGEN(b.x)]) == gen, bar);
            __builtin_amdgcn_fence(__ATOMIC_ACQUIRE, "agent");
            asm volatile("s_waitcnt vmcnt(0)" ::: "memory");
        }
    }
    __syncthreads();
}

struct Args { const float* in[30]; float* out; unsigned char* ws; int ph_lo, ph_hi, use_bar, pad; };
struct Frame {
    LAS unsigned char* lds;
    int tid, lane, wave, vcu, G;
    unsigned char* ws;
};
typedef const __attribute__((address_space(4))) Args* KA;
__device__ __forceinline__ KA kargs() { KA p = (KA)__builtin_amdgcn_kernarg_segment_ptr(); asm volatile("" : "+s"(p)); return p; }
__device__ __forceinline__ Frame mk_frame(KA A) {
    Frame F; F.lds = (LAS unsigned char*)0; F.tid = ltid(); F.lane = F.tid & 63; F.wave = __builtin_amdgcn_readfirstlane(F.tid >> 6);
    F.G = gridDim.x; { const int bx = lbid(); F.vcu = (F.G % 8 == 0) ? (bx % 8) * (F.G / 8) + bx / 8 : bx; }
    F.ws = A->ws; return F;
}
enum { I_X = 0, I_C, I_CTX, I_CCTX, I_WMOD, I_BMOD, I_NMIX, I_NFFN, I_WIN, I_CONVW, I_DW0, I_DW2, I_A0, I_A2, I_G2, I_KEYK, I_KEYA, I_RHO, I_GNG, I_GNB, I_QN, I_KN, I_WBR, I_WBA, I_WOUT, I_WROUTER, I_WGATE, I_WUP, I_WDOWN, I_NFINAL };

__device__ __forceinline__ float wave_sum(float v) {
#pragma unroll
    for (int o = 1; o < 64; o <<= 1) v += __shfl_xor(v, o);
    return v;
}
__device__ __forceinline__ float sum8(float v) { v += __shfl_xor(v, 1); v += __shfl_xor(v, 2); v += __shfl_xor(v, 4); return v; }
#define DPP_ROR_ADD(x, n) (x) += __builtin_bit_cast(float, __builtin_amdgcn_update_dpp(0, __builtin_bit_cast(int, (x)), 0x120 + (n), 0xf, 0xf, false))
__device__ __forceinline__ float red16(float x) { DPP_ROR_ADD(x, 8); DPP_ROR_ADD(x, 4); DPP_ROR_ADD(x, 2); DPP_ROR_ADD(x, 1); return x; }

__device__ __forceinline__ void transpose_item(const float* W, int K, int N, int k0, int n0, bf16* dst, int ldd, LAS float* scr, int lane) {
#pragma unroll 8
    for (int i = 0; i < 32; ++i) { const int kk = 2 * i + (lane >> 5); scr[kk * 33 + (lane & 31)] = W[(size_t)(k0 + kk) * N + n0 + (lane & 31)]; }
    LDS_WAIT(); asm volatile("" ::: "memory");
    const int c = lane & 7;
#pragma unroll
    for (int j = 0; j < 4; ++j) { const int n = (lane >> 3) + 8 * j; const LAS float* s = scr + (8 * c) * 33 + n;
        v4u o; o.x = pk2(s[0 * 33], s[1 * 33]); o.y = pk2(s[2 * 33], s[3 * 33]); o.z = pk2(s[4 * 33], s[5 * 33]); o.w = pk2(s[6 * 33], s[7 * 33]);
        *(GAS v4u*)(dst + (size_t)n * ldd + k0 + 8 * c) = o; }
    LDS_WAIT(); asm volatile("" ::: "memory");
}
__device__ __forceinline__ void transpose_matrix(const Frame& F, const float* W, int K, int N, bf16* WT, int ldd, LAS float* scr, int& itbase) {
    const int gw = F.vcu * NWAVES + F.wave, NGW = F.G * NWAVES;
    const int nblk = N / 32, nit = (K / 64) * nblk;
    int it = ((gw - itbase) % NGW + NGW) % NGW;
    for (; it < nit; it += NGW) { const int kb = it / nblk, nb = it % nblk; transpose_item(W, K, N, 64 * kb, 32 * nb, WT + (size_t)(32 * nb) * ldd, ldd, scr, F.lane); }
    itbase = (itbase + nit) % NGW;
}
__device__ __forceinline__ void cvt_moe(const Frame& F, KA A, int l) {
    LAS float* scr = (LAS float*)(F.lds + RING_OFF + F.wave * 16384);
    const int gw = F.vcu * NWAVES + F.wave, NGW = F.G * NWAVES;
    bf16* Wgu = (bf16*)(F.ws + WS_WGU); bf16* Wd = (bf16*)(F.ws + WS_WD);
    constexpr int IT_G = 16 * 88, IT_D = 44 * 32, PER_E = 2 * IT_G + IT_D;
    for (int it = gw; it < NE * PER_E; it += NGW) {
        const int e = it / PER_E; int r = it % PER_E;
        if (r < 2 * IT_G) { const int up = r >= IT_G; if (up) r -= IT_G; const int kb = r / 88, nb = r % 88, n0 = 32 * nb;
            const float* W = (up ? A->in[I_WUP] : A->in[I_WGATE]) + ((size_t)l * NE + e) * DM * FF;
            transpose_item(W, DM, FF, 64 * kb, n0, Wgu + ((size_t)e * 2 * FF + 256 * (n0 >> 7) + (n0 & 127) + (up ? 128 : 0)) * DM, DM, scr, F.lane);
        } else { r -= 2 * IT_G; const int kb = r / 32, nb = r % 32;
            const float* W = A->in[I_WDOWN] + ((size_t)l * NE + e) * FF * DM;
            transpose_item(W, FF, DM, 64 * kb, 32 * nb, Wd + ((size_t)e * DM + 32 * nb) * FF, FF, scr, F.lane); }
    }
}
__device__ __forceinline__ void p_prologue() {
    KA A = kargs(); const Frame F = mk_frame(A);
    const int gw = F.vcu * NWAVES + F.wave, NGW = F.G * NWAVES;
    const int gt = (F.vcu * NWAVES * 64) + F.tid, NGT = F.G * NWAVES * 64;
    {
        LAS float* SC = (LAS float*)(F.lds);
        LAS float* PS = (LAS float*)(F.lds + 32768);
        if ((int)blockIdx.x < 192) {
            for (int i = F.tid; i < 5 * 1024; i += NWAVES * 64) { const int v = i >> 10, k = i & 1023; const float cv = v < 4 ? A->in[I_C][v * 1024 + k] : A->in[I_CCTX][k]; SC[i] = cv / (1.0f + expf(-cv)); }
            __syncthreads();
            for (int it = blockIdx.x; it < 192; it += F.G) {
                const int l = it / 96, col = (it % 96) * 64 + F.lane;
                const float* W = A->in[I_WMOD] + (size_t)l * DM * 6144 + col;
                float a0 = 0.f, a1 = 0.f, a2 = 0.f, a3 = 0.f, a4 = 0.f;
                const int kb = F.wave * 128;
#pragma unroll 4
                for (int k = 0; k < 128; ++k) { const float w = W[(size_t)(kb + k) * 6144];
                    a0 += SC[kb + k] * w; a1 += SC[1024 + kb + k] * w; a2 += SC[2048 + kb + k] * w; a3 += SC[3072 + kb + k] * w; a4 += SC[4096 + kb + k] * w; }
                PS[(F.wave * 5 + 0) * 64 + F.lane] = a0; PS[(F.wave * 5 + 1) * 64 + F.lane] = a1; PS[(F.wave * 5 + 2) * 64 + F.lane] = a2; PS[(F.wave * 5 + 3) * 64 + F.lane] = a3; PS[(F.wave * 5 + 4) * 64 + F.lane] = a4;
                __syncthreads();
                if (F.tid < 320) { const int v = F.tid >> 6, cl = F.tid & 63; float s = 0.f;
#pragma unroll
                    for (int w = 0; w < 8; ++w) s += PS[(w * 5 + v) * 64 + cl];
                    const int c2 = (it % 96) * 64 + cl;
                    ((float*)(F.ws + WS_MODV))[((size_t)l * 5 + v) * 6144 + c2] = s + A->in[I_BMOD][l * 6144 + c2]; }
                __syncthreads();
            }
        }
        __syncthreads();
    }
    for (int i = gt; i < TL * 32; i += NGT) { const int t = i >> 5, e = i & 31, ax = e >> 4, pr = e & 15;
        const float pos = (float)(ax == 0 ? (t >> 6) : (t & 63)); const float inv = powf(10000.0f, -(float)pr / 16.0f); const float ang = pos * inv;
        ((float2*)(F.ws + WS_ROPE))[i] = make_float2(cosf(ang), sinf(ang)); }
    for (int i = gt; i < 2 * LOC * LK; i += NGT) { const int l = i / (LOC * LK), r = i % (LOC * LK), n = r / LK, k = r % LK; float v = 0.f;
        if (n < 512) { if (k < 160) v = A->in[I_G2][((size_t)l * 160 + k) * 512 + n]; }
        else if (n < 1536) { const int z = (n - 512) >> 9, c = (n - 512) & 511, k0 = 256 + 128 * z; if (k >= k0 && k < k0 + 64) v = A->in[I_DW2][(((size_t)l * 2 + z) * 64 + (k - k0)) * 512 + c]; }
        else { const int z = (n - 1536) >> 9, c = (n - 1536) & 511, k0 = 512 + 128 * z; if (k >= k0 && k < k0 + 64) v = A->in[I_A2][(((size_t)l * 2 + z) * 64 + (k - k0)) * 512 + c]; }
        ((bf16*)(F.ws + WS_WLORA))[i] = (bf16)f2bf(v); }
    for (int i = gt; i < 2 * (UC - IN_COLS) * DM / 8; i += NGT) { const int l = i / ((UC - IN_COLS) * DM / 8), r = i % ((UC - IN_COLS) * DM / 8);
        ((GAS v4u*)(F.ws + WS_WIN + ((size_t)l * UC + IN_COLS) * DM * 2))[r] = (v4u){0u, 0u, 0u, 0u}; }
    LAS float* scr = (LAS float*)(F.lds + RING_OFF + F.wave * 16384);
    int itbase = 0;
#pragma unroll 1
    for (int l = 0; l < NLAYER; ++l) {
        transpose_matrix(F, A->in[I_WIN] + (size_t)l * DM * IN_COLS, DM, IN_COLS, (bf16*)(F.ws + WS_WIN) + (size_t)l * UC * DM, DM, scr, itbase);
        transpose_matrix(F, A->in[I_WBR] + (size_t)l * 512 * DM, 512, DM, (bf16*)(F.ws + WS_WBR) + (size_t)l * DM * DM, DM, scr, itbase);
        transpose_matrix(F, A->in[I_WBA] + (size_t)l * 512 * DM, 512, DM, (bf16*)(F.ws + WS_WBR) + (size_t)l * DM * DM + 512, DM, scr, itbase);
        transpose_matrix(F, A->in[I_WOUT] + (size_t)l * DM * DM, DM, DM, (bf16*)(F.ws + WS_WOUT) + (size_t)l * DM * DM, DM, scr, itbase);
    }
    cvt_moe(F, A, 0);
}

template <int MODE> __device__ __forceinline__ void p_rownorm() {
    KA A = kargs(); const Frame F = mk_frame(A);
    const int gw = F.vcu * NWAVES + F.wave, NGW = F.G * NWAVES;
    constexpr int l = MODE == 0 ? 0 : 1, lprev = MODE == 2 ? 1 : 0;
    float* X = (float*)(F.ws + WS_X); bf16* H = (bf16*)(F.ws + WS_H);
    const float* modv = (const float*)(F.ws + WS_MODV);
    const int* TOKMAP = (const int*)(F.ws + WS_TOKMAP); const bf16* YE = (const bf16*)(F.ws + WS_XE);
    for (int row = gw; row < MR; row += NGW) {
        const int b = row / TP, p = row % TP, sel = p < TCX ? 4 : b;
        if (MODE == 2 && p < TCX) continue;
        const float* src = MODE == 0 ? (p < TCX ? A->in[I_CTX] + ((size_t)b * TCX + p) * DM : A->in[I_X] + ((size_t)b * TL + (p - TCX)) * DM) : X + (size_t)row * DM;
        f32x4 v[4];
#pragma unroll
        for (int j = 0; j < 4; ++j) v[j] = *(const GAS f32x4*)(src + 4 * F.lane + 256 * j);
        if (MODE >= 1) {
            const int tm = TOKMAP[(size_t)row * 16 + (F.lane & 15)];
            f32x4 acc[4];
#pragma unroll
            for (int j = 0; j < 4; ++j) acc[j] = (f32x4){0.f, 0.f, 0.f, 0.f};
#pragma unroll
            for (int e = 0; e < 16; ++e) { const int sr = __builtin_amdgcn_readlane(tm, e);
                if (sr >= 0) { const bf16* yr = YE + (size_t)sr * DM + 4 * F.lane;
#pragma unroll
                    for (int j = 0; j < 4; ++j) { const v2u w = *(const GAS v2u*)(yr + 256 * j); acc[j][0] += bflo(w.x); acc[j][1] += bfhi(w.x); acc[j][2] += bflo(w.y); acc[j][3] += bfhi(w.y); } } }
            const float* g2 = modv + ((size_t)lprev * 5 + sel) * 6144 + 5 * 1024 + 4 * F.lane;
#pragma unroll
            for (int j = 0; j < 4; ++j) v[j] += *(const f32x4*)(g2 + 256 * j) * acc[j];
        }
        float ss = 0.f;
#pragma unroll
        for (int j = 0; j < 4; ++j) ss += (v[j][0] * v[j][0] + v[j][1] * v[j][1]) + (v[j][2] * v[j][2] + v[j][3] * v[j][3]);
        const float rinv = 1.0f / sqrtf(wave_sum(ss) * (1.0f / DM) + NORM_EPS);
        if (MODE == 2) {
            float* o = A->out + ((size_t)b * TL + (p - TCX)) * DM + 4 * F.lane; const float* nf = A->in[I_NFINAL] + 4 * F.lane;
#pragma unroll
            for (int j = 0; j < 4; ++j) *(GAS f32x4*)(o + 256 * j) = v[j] * rinv * *(const f32x4*)(nf + 256 * j);
        } else {
            const float* nw = A->in[I_NMIX] + l * DM + 4 * F.lane; const float* sh = modv + ((size_t)l * 5 + sel) * 6144 + 4 * F.lane; const float* sc = sh + 1024;
            bf16* ho = H + (size_t)row * DM + 4 * F.lane; float* xo = X + (size_t)row * DM + 4 * F.lane;
#pragma unroll
            for (int j = 0; j < 4; ++j) { *(GAS f32x4*)(xo + 256 * j) = v[j];
                const f32x4 hh = v[j] * rinv * *(const f32x4*)(nw + 256 * j) * (1.0f + *(const f32x4*)(sc + 256 * j)) + *(const f32x4*)(sh + 256 * j);
                v2u w; w.x = pk2(hh[0], hh[1]); w.y = pk2(hh[2], hh[3]); *(GAS v2u*)(ho + 256 * j) = w; }
        }
    }
}

__device__ __forceinline__ void ld8(const bf16* p, float (&o)[8]) { const v4u w = *(const GAS v4u*)p; o[0] = bflo(w.x); o[1] = bfhi(w.x); o[2] = bflo(w.y); o[3] = bfhi(w.y); o[4] = bflo(w.z); o[5] = bfhi(w.z); o[6] = bflo(w.w); o[7] = bfhi(w.w); }
__device__ __forceinline__ void up8(const v4u& w, float (&o)[8]) { o[0] = bflo(w.x); o[1] = bfhi(w.x); o[2] = bflo(w.y); o[3] = bfhi(w.y); o[4] = bflo(w.z); o[5] = bfhi(w.z); o[6] = bflo(w.w); o[7] = bfhi(w.w); }
__device__ __forceinline__ void st8(bf16* p, const float (&o)[8]) { v4u w; w.x = pk2(o[0], o[1]); w.y = pk2(o[2], o[3]); w.z = pk2(o[4], o[5]); w.w = pk2(o[6], o[7]); *(GAS v4u*)p = w; }
__device__ __forceinline__ void ldf8(const float* p, float (&o)[8]) { const f32x4 a = *(const f32x4*)p, b = *(const f32x4*)(p + 4); o[0] = a[0]; o[1] = a[1]; o[2] = a[2]; o[3] = a[3]; o[4] = b[0]; o[5] = b[1]; o[6] = b[2]; o[7] = b[3]; }
__device__ __forceinline__ void p_prep_a(int l) {
    KA A = kargs(); const Frame F = mk_frame(A);
    const int gw = F.vcu * NWAVES + F.wave, NGW = F.G * NWAVES, lane = F.lane;
    const bf16* U = (const bf16*)(F.ws + WS_U); bf16* RKV = (bf16*)(F.ws + WS_RKV); bf16* L = (bf16*)(F.ws + WS_L);
    bf16* Q = (bf16*)(F.ws + WS_Q); bf16* KB = (bf16*)(F.ws + WS_KB); bf16* VB = (bf16*)(F.ws + WS_VB);
    const float* cw = A->in[I_CONVW] + (size_t)l * 3 * RWKV_COLS; const float* qn = A->in[I_QN] + l * 64; const float* kn = A->in[I_KN] + l * 64;
    const float2* rope = (const float2*)(F.ws + WS_ROPE);
    constexpr int RB = 16, NRB = MR / RB, NITEM = NRB * 5;
    for (int it = gw; it < NITEM; it += NGW) {
        const int rb = it / 5, pass = it % 5, r0 = rb * RB, p0 = r0 % TP;
        if (pass < 4) {
            const int s = 64 * pass + lane; const bool act = s < 244; const int c0 = act ? 8 * s : 0;
            float w0[8], w1[8], w2[8];
            ldf8(cw + c0, w0); ldf8(cw + RWKV_COLS + c0, w1); ldf8(cw + 2 * RWKV_COLS + c0, w2);
            const bf16* up = U + (size_t)r0 * UC + c0;
            const v4u zero = (v4u){0u, 0u, 0u, 0u};
            v4u a = (p0 != 0 && p0 != TCX) ? *(const GAS v4u*)(up - UC) : zero, b = *(const GAS v4u*)up, c = *(const GAS v4u*)(up + UC), d;
#pragma unroll 4
            for (int t = 0; t < RB; ++t) {
                const int p = p0 + t; const bool hn = (p != TCX - 1 && p != TP - 1);
                const bool hn2 = (p + 1 != TCX - 1 && p + 1 != TP - 1) && hn;
                d = hn2 ? *(const GAS v4u*)(up + (size_t)(t + 2) * UC) : zero;
                float fa[8], fb[8], fc[8], o[8];
                up8(a, fa); up8(b, fb); up8(hn ? c : zero, fc);
#pragma unroll
                for (int e = 0; e < 8; ++e) o[e] = fa[e] * w0[e] + fb[e] * w1[e] + fc[e] * w2[e];
                const size_t row = (size_t)(r0 + t);
                if (pass < 3) st8(RKV + row * 1536 + c0, o);
                else if (act) { const int lo = c0 - 1536;
                    if (lo < 160) {
#pragma unroll
                        for (int e = 0; e < 8; ++e) o[e] = __builtin_amdgcn_rcpf(1.0f + __expf(-o[e])); }
                    else if (lo < 288) {
#pragma unroll
                        for (int e = 0; e < 8; ++e) o[e] = 1.0f - 2.0f * __builtin_amdgcn_rcpf(1.0f + __expf(2.0f * o[e])); }
                    const int lc = lo < 160 ? lo : (lo < 224 ? 256 + (lo - 160) : (lo < 288 ? 384 + (lo - 224) : (lo < 352 ? 512 + (lo - 288) : 640 + (lo - 352))));
                    st8(L + row * LK + lc, o); }
                if (pass == 3 && lane < 44) {
                    const int pc = lane < 12 ? 160 + 8 * lane : (lane < 20 ? 320 + 8 * (lane - 12) : (lane < 28 ? 448 + 8 * (lane - 20) : (lane < 36 ? 576 + 8 * (lane - 28) : 704 + 8 * (lane - 36))));
                    *(GAS v4u*)(L + row * LK + pc) = zero; }
                a = hn ? b : zero; b = c; c = d;
            }
        } else {
            const int m = lane & 7, ax = m >> 2, hf = (m >> 1) & 1, sl = lane & 15;
            float gq[8], gk[8]; ldf8(qn + 8 * m, gq); ldf8(kn + 8 * m, gk);
#pragma unroll 2
            for (int t = 0; t < RB; ++t) {
                const int p = p0 + t; const bool isctx = p < TCX; const size_t row = (size_t)(r0 + t);
                const bf16* u0 = U + row * UC;
                const v4u qw = *(const GAS v4u*)(u0 + U_Q + 8 * lane), kw = *(const GAS v4u*)(u0 + U_KQ + 8 * sl), vw = *(const GAS v4u*)(u0 + U_VQ + 8 * sl);
                float cs[8], sn[8];
                if (!isctx) { const float2* rp = rope + (size_t)(p - TCX) * 32 + ax * 16 + 8 * (m & 1);
#pragma unroll
                    for (int e = 0; e < 8; e += 2) { const f32x4 tt = *(const f32x4*)(rp + e); cs[e] = tt[0]; sn[e] = tt[1]; cs[e + 1] = tt[2]; sn[e + 1] = tt[3]; } }
                else {
#pragma unroll
                    for (int e = 0; e < 8; ++e) { cs[e] = 1.f; sn[e] = 0.f; } }
                float q[8], k[8]; up8(qw, q); up8(kw, k);
                float sq = 0.f, sk = 0.f;
#pragma unroll
                for (int e = 0; e < 8; ++e) { sq += q[e] * q[e]; sk += k[e] * k[e]; }
                const float rq = __builtin_amdgcn_rsqf(sum8(sq) * (1.0f / 64.0f) + NORM_EPS), rk = __builtin_amdgcn_rsqf(sum8(sk) * (1.0f / 64.0f) + NORM_EPS);
                float oq[8], ok[8];
#pragma unroll
                for (int e = 0; e < 8; ++e) { q[e] = q[e] * rq * gq[e]; k[e] = k[e] * rk * gk[e]; }
#pragma unroll
                for (int e = 0; e < 8; ++e) { const float pq = __shfl_xor(q[e], 2), pk = __shfl_xor(k[e], 2);
                    oq[e] = (hf == 0 ? q[e] * cs[e] - pq * sn[e] : q[e] * cs[e] + pq * sn[e]) * QSCALE;
                    ok[e] = (hf == 0 ? k[e] * cs[e] - pk * sn[e] : k[e] * cs[e] + pk * sn[e]); }
                st8(Q + row * 512 + 8 * lane, oq);
                if (lane < 16) st8(KB + row * 128 + 8 * sl, ok);
                else if (lane < 32) *(GAS v4u*)(VB + row * 128 + 8 * sl) = vw;
            }
        }
    }
}

__device__ __forceinline__ void p_post(int l) {
    KA A = kargs(); const Frame F = mk_frame(A);
    const int gw = F.vcu * NWAVES + F.wave, NGW = F.G * NWAVES, lane = F.lane, c0 = 8 * lane;
    const bf16* Y = (const bf16*)(F.ws + WS_Y); const bf16* RKV = (const bf16*)(F.ws + WS_RKV); const bf16* LO = (const bf16*)(F.ws + WS_LO); bf16* YR = (bf16*)(F.ws + WS_YO);
    float gg[8], gb[8], ka[8], rho[8];
    ldf8(A->in[I_GNG] + l * 512 + c0, gg); ldf8(A->in[I_GNB] + l * 512 + c0, gb); ldf8(A->in[I_KEYA] + l * 512 + c0, ka); ldf8(A->in[I_RHO] + l * 512 + c0, rho);
    for (int row = gw; row < MR; row += NGW) {
        if (l == NLAYER - 1 && (row % TP) < TCX) continue;
        float y[8], y1[8]; ld8(Y + (size_t)row * 512 + c0, y); ld8(Y + ((size_t)MR + row) * 512 + c0, y1);
        float s = 0.f;
#pragma unroll
        for (int e = 0; e < 8; ++e) { y[e] += y1[e]; s += y[e]; }
        const float mu = sum8(s) * (1.0f / 64.0f); float q = 0.f;
#pragma unroll
        for (int e = 0; e < 8; ++e) { y[e] -= mu; q += y[e] * y[e]; }
        const float rstd = 1.0f / sqrtf(sum8(q) * (1.0f / 64.0f) + GN_EPS);
        float r[8], k[8], v[8], a0[8], a1[8], g[8];
        ld8(RKV + (size_t)row * 1536 + c0, r); ld8(RKV + (size_t)row * 1536 + 512 + c0, k); ld8(RKV + (size_t)row * 1536 + 1024 + c0, v);
        ld8(LO + (size_t)row * LOC + 1536 + c0, a0); ld8(LO + (size_t)row * LOC + 2048 + c0, a1); ld8(LO + (size_t)row * LOC + c0, g);
        float bs = 0.f;
#pragma unroll
        for (int e = 0; e < 8; ++e) { const float kr = k[e] * (1.0f + (a0[e] - 1.0f) * ka[e]) + k[e] * (1.0f + (a1[e] - 1.0f) * ka[e]); bs += r[e] * kr * rho[e]; }
        const float bon = sum8(bs);
        float o[8];
#pragma unroll
        for (int e = 0; e < 8; ++e) o[e] = ((y[e] * rstd * gg[e] + gb[e]) + bon * v[e]) * g[e];
        st8(YR + (size_t)row * 1024 + c0, o);
    }
}

#define DPPF(x, ctrl) __builtin_bit_cast(float, __builtin_amdgcn_update_dpp(0, __builtin_bit_cast(int, (x)), (ctrl), 0xf, 0xf, false))
__device__ __forceinline__ float reduce16_to_lane(const float (&p)[16], int lane) {
    const bool b3 = lane & 8, b2 = lane & 4, b1 = lane & 2, b0 = lane & 1;
    float q8[8], q4[4], q2[2];
#pragma unroll
    for (int e = 0; e < 8; ++e) { const float keep = b3 ? p[e + 8] : p[e], send = b3 ? p[e] : p[e + 8]; q8[e] = keep + DPPF(send, 0x140); }
#pragma unroll
    for (int e = 0; e < 4; ++e) { const float keep = b2 ? q8[e + 4] : q8[e], send = b2 ? q8[e] : q8[e + 4]; q4[e] = keep + DPPF(send, 0x141); }
#pragma unroll
    for (int e = 0; e < 2; ++e) { const float keep = b1 ? q4[e + 2] : q4[e], send = b1 ? q4[e] : q4[e + 2]; q2[e] = keep + DPPF(send, 0x4E); }
    const float keep = b0 ? q2[1] : q2[0], send = b0 ? q2[0] : q2[1];
    float x = keep + DPPF(send, 0xB1);
    x += __shfl_xor(x, 16); x += __shfl_xor(x, 32);
    return x;
}
__device__ __forceinline__ float rowmax16(float x) { x = fmaxf(x, DPPF(x, 0x128)); x = fmaxf(x, DPPF(x, 0x124)); x = fmaxf(x, DPPF(x, 0x122)); x = fmaxf(x, DPPF(x, 0x121)); return x; }
__device__ __forceinline__ void p_norm2(int l) {
    KA A = kargs(); const Frame F = mk_frame(A);
    const int gw = F.vcu * NWAVES + F.wave, NGW = F.G * NWAVES, lane = F.lane;
    LAS float* WRt = (LAS float*)(F.lds);
    for (int i = F.tid; i < 16 * 1024; i += NWAVES * 64) { const int e = i >> 10, c = i & 1023; WRt[i] = A->in[I_WROUTER][(size_t)l * DM * 16 + c * 16 + e]; }
    __syncthreads();
    const float* X = (const float*)(F.ws + WS_X); bf16* H = (bf16*)(F.ws + WS_H); float* AFF = (float*)(F.ws + WS_AFF);
    const float* modv = (const float*)(F.ws + WS_MODV);
    const bool lat_only = (l == NLAYER - 1); const int nrows = lat_only ? NB * TL : MR;
#define N2_ROW(q) (lat_only ? ((q) / TL) * TP + TCX + ((q) % TL) : (q))
    f32x4 nx[4];
    if (gw < nrows) { const int row = N2_ROW(gw);
#pragma unroll
        for (int j = 0; j < 4; ++j) nx[j] = *(const GAS f32x4*)(X + (size_t)row * DM + 4 * lane + 256 * j); }
    for (int q = gw; q < nrows; q += NGW) {
        const int row = N2_ROW(q), b = row / TP, p = row % TP, sel = p < TCX ? 4 : b;
        f32x4 v[4];
#pragma unroll
        for (int j = 0; j < 4; ++j) v[j] = nx[j];
        if (q + NGW < nrows) { const int rown = N2_ROW(q + NGW);
#pragma unroll
            for (int j = 0; j < 4; ++j) nx[j] = *(const GAS f32x4*)(X + (size_t)rown * DM + 4 * lane + 256 * j); }
        float ss = 0.f;
#pragma unroll
        for (int j = 0; j < 4; ++j) ss += (v[j][0] * v[j][0] + v[j][1] * v[j][1]) + (v[j][2] * v[j][2] + v[j][3] * v[j][3]);
        const float rinv = 1.0f / sqrtf(wave_sum(ss) * (1.0f / DM) + NORM_EPS);
        const float* nw = A->in[I_NFFN] + l * DM + 4 * lane; const float* sh = modv + ((size_t)l * 5 + sel) * 6144 + 3 * 1024 + 4 * lane; const float* sc = sh + 1024;
        bf16* ho = H + (size_t)row * DM + 4 * lane;
#pragma unroll
        for (int j = 0; j < 4; ++j) { v[j] = v[j] * rinv * *(const f32x4*)(nw + 256 * j) * (1.0f + *(const f32x4*)(sc + 256 * j)) + *(const f32x4*)(sh + 256 * j);
            v2u w; w.x = pk2(v[j][0], v[j][1]); w.y = pk2(v[j][2], v[j][3]); *(GAS v2u*)(ho + 256 * j) = w; }
        float lg[16];
        const unsigned wad = 16u * (unsigned)lane;
#pragma unroll
        for (int g = 0; g < 4; ++g) {
            f32x4 w[4][4];
            asm volatile("ds_read_b128 %0, %16 offset:%17\n\tds_read_b128 %1, %16 offset:%17+1024\n\tds_read_b128 %2, %16 offset:%17+2048\n\tds_read_b128 %3, %16 offset:%17+3072\n\t"
                         "ds_read_b128 %4, %16 offset:%17+4096\n\tds_read_b128 %5, %16 offset:%17+5120\n\tds_read_b128 %6, %16 offset:%17+6144\n\tds_read_b128 %7, %16 offset:%17+7168\n\t"
                         "ds_read_b128 %8, %16 offset:%17+8192\n\tds_read_b128 %9, %16 offset:%17+9216\n\tds_read_b128 %10, %16 offset:%17+10240\n\tds_read_b128 %11, %16 offset:%17+11264\n\t"
                         "ds_read_b128 %12, %16 offset:%17+12288\n\tds_read_b128 %13, %16 offset:%17+13312\n\tds_read_b128 %14, %16 offset:%17+14336\n\tds_read_b128 %15, %16 offset:%17+15360\n\t"
                         "s_waitcnt lgkmcnt(0)"
                : "=&v"(w[0][0]), "=&v"(w[0][1]), "=&v"(w[0][2]), "=&v"(w[0][3]), "=&v"(w[1][0]), "=&v"(w[1][1]), "=&v"(w[1][2]), "=&v"(w[1][3]),
                  "=&v"(w[2][0]), "=&v"(w[2][1]), "=&v"(w[2][2]), "=&v"(w[2][3]), "=&v"(w[3][0]), "=&v"(w[3][1]), "=&v"(w[3][2]), "=&v"(w[3][3])
                : "v"(wad), "i"(g * 16384) : "memory");
#pragma unroll
            for (int ee = 0; ee < 4; ++ee) { float s = 0.f;
#pragma unroll
                for (int j = 0; j < 4; ++j) s += (v[j][0] * w[ee][j][0] + v[j][1] * w[ee][j][1]) + (v[j][2] * w[ee][j][2] + v[j][3] * w[ee][j][3]);
                lg[4 * g + ee] = s; }
        }
        const float mylg = reduce16_to_lane(lg, lane);
        const float mx = rowmax16(mylg);
        const float ex = expf(mylg - mx);
        const float den = red16(ex);
        if (lane < 16) AFF[(size_t)row * 16 + lane] = ex / den;
    }
#undef N2_ROW
    __syncthreads();
}

__device__ __forceinline__ int block_excl_scan(int v, LAS int* tmp, int tid, int lane, int wave, int& total) {
    int inc = v;
#pragma unroll
    for (int o = 1; o < 64; o <<= 1) { const int t = __shfl_up(inc, o); if (lane >= o) inc += t; }
    __syncthreads();
    if (lane == 63) tmp[wave] = inc;
    __syncthreads();
    int base = 0, tot = 0;
#pragma unroll
    for (int w = 0; w < NWAVES; ++w) { const int t = tmp[w]; if (w < wave) base += t; tot += t; }
    total = tot;
    return base + inc - v;
}
__device__ __forceinline__ void p_topk(int l) {
    KA A = kargs(); const Frame F = mk_frame(A);
    LAS int* hist = (LAS int*)(F.lds);
    LAS int* hist2 = hist + 256;
    LAS int* sel = hist + 512;
    LAS int* tmp = hist + 528;
    const float* AFF = (const float*)(F.ws + WS_AFF); int* TOKMAP = (int*)(F.ws + WS_TOKMAP); int* IDX = (int*)(F.ws + WS_IDX); float* GATEV = (float*)(F.ws + WS_GATEV);
    const int nprob = (l == 0) ? 128 : 64, tid = F.tid;
    for (int pid = blockIdx.x; pid < nprob; pid += F.G) {
        const bool isc = pid >= 64; const int q = pid & 63, b = q >> 4, e = q & 15;
        const int n = isc ? TCX : TL, C = isc ? CAP_C : CAP_L, rowbase = b * TP + (isc ? 0 : TCX);
        const int slotbase = isc ? (SLOT_L + e * 256 + b * CAP_C) : (e * (NB * CAP_L) + b * CAP_L);
        const int t0 = 16 * tid; const bool valid = t0 < n;
        unsigned key[16];
#pragma unroll
        for (int k = 0; k < 16; ++k) key[k] = valid ? __float_as_uint(AFF[(size_t)(rowbase + t0 + k) * 16 + e]) : 0u;
        unsigned prefix = 0u, mask = 0u; int remaining = C;
#pragma unroll 1
        for (int pass = 0; pass < 4; ++pass) { const int shift = 24 - 8 * pass;
            if (tid < 256) hist[tid] = 0;
            __syncthreads();
            if (valid) {
#pragma unroll
                for (int k = 0; k < 16; ++k) if ((key[k] & mask) == prefix) atomicAdd((int*)&hist[(key[k] >> shift) & 255u], 1); }
            __syncthreads();
            LAS int* src = hist; LAS int* dst = hist2;
#pragma unroll 1
            for (int off = 1; off < 256; off <<= 1) { if (tid < 256) dst[tid] = src[tid] + (tid + off < 256 ? src[tid + off] : 0); __syncthreads(); LAS int* t = src; src = dst; dst = t; }
            if (tid < 256) { const int sd = src[tid], sn = tid < 255 ? src[tid + 1] : 0; if (sd >= remaining && sn < remaining) { sel[0] = tid; sel[1] = remaining - sn; } }
            __syncthreads();
            prefix |= (unsigned)sel[0] << shift; mask |= 255u << shift; remaining = sel[1];
            __syncthreads();
        }
        int ceq = 0;
#pragma unroll
        for (int k = 0; k < 16; ++k) ceq += (valid && key[k] == prefix) ? 1 : 0;
        int tot; int eqrank = block_excl_scan(ceq, tmp, tid, F.lane, F.wave, tot);
        unsigned selmask = 0u; int csel = 0;
#pragma unroll
        for (int k = 0; k < 16; ++k) { bool s = false; if (valid) { if (key[k] > prefix) s = true; else if (key[k] == prefix) { s = eqrank < remaining; ++eqrank; } } if (s) { selmask |= 1u << k; ++csel; } }
        int pos = block_excl_scan(csel, tmp, tid, F.lane, F.wave, tot);
        if (valid) {
#pragma unroll
            for (int k = 0; k < 16; ++k) { const int row = rowbase + t0 + k;
                if (selmask & (1u << k)) { const int sr = slotbase + pos; ++pos; IDX[sr] = row; GATEV[sr] = __uint_as_float(key[k]); TOKMAP[(size_t)row * 16 + e] = sr; }
                else TOKMAP[(size_t)row * 16 + e] = -1; } }
        if (isc && b == 0 && tid >= 128 && tid < 256) { IDX[SLOT_L + e * 256 + tid] = -1; GATEV[SLOT_L + e * 256 + tid] = 0.f; }
        __syncthreads();
    }
}

__device__ __forceinline__ void p_gather(int l) {
    KA A = kargs(); const Frame F = mk_frame(A);
    const int gw = F.vcu * NWAVES + F.wave, NGW = F.G * NWAVES, lane = F.lane;
    const bf16* H = (const bf16*)(F.ws + WS_H); bf16* XE = (bf16*)(F.ws + WS_XE); const int* IDX = (const int*)(F.ws + WS_IDX);
    const int ns = (l == 0) ? SLOT_ALL : SLOT_L;
    for (int sr = gw; sr < ns; sr += NGW) { const int idx = IDX[sr];
        v4u a = (v4u){0u, 0u, 0u, 0u}, b2 = a;
        if (idx >= 0) { a = *(const GAS v4u*)(H + (size_t)idx * DM + 8 * lane); b2 = *(const GAS v4u*)(H + (size_t)idx * DM + 512 + 8 * lane); }
        *(GAS v4u*)(XE + (size_t)sr * DM + 8 * lane) = a; *(GAS v4u*)(XE + (size_t)sr * DM + 512 + 8 * lane) = b2; }
}
constexpr int SC_CH = 32, SC_STR = 340, SC_NC = TP / SC_CH;
__device__ __forceinline__ int scan_p(int s, int z) { return z == 0 ? s : (s < TCX ? (TCX - 1 - s) : (TP + TCX - 1 - s)); }
#define SC_BAR() asm volatile("s_waitcnt lgkmcnt(0)\n\ts_barrier" ::: "memory")
struct ScanRaw { v4u r, k, a, w, v; };
__device__ __forceinline__ void scan_ldraw(ScanRaw& R, int c, int lw, int lane, int b, int h, int z, int rg, const bf16* RKV, const bf16* LO) {
    const int sg = lane >> 3, ko = lane & 7, s = c * SC_CH + 8 * lw + sg; const size_t row = (size_t)b * TP + scan_p(s, z);
    const bf16* rp = RKV + row * 1536 + h * 64 + 8 * ko; const bf16* lp = LO + row * LOC + 512 * z + h * 64 + 8 * ko;
    R.r = *(const GAS v4u*)rp; R.k = *(const GAS v4u*)(rp + 512); R.a = *(const GAS v4u*)(lp + 1536); R.w = *(const GAS v4u*)(lp + 512);
    R.v = *(const GAS v4u*)(RKV + row * 1536 + 1024 + h * 64 + 16 * rg + 8 * (ko & 1));
}
__device__ __forceinline__ float h2f(unsigned short u) { return (float)__builtin_bit_cast(_Float16, u); }
__device__ __forceinline__ void scan_put(const ScanRaw& R, int c, int lw, int lane, LAS float* lds0, const float (&keyk)[8], const float (&keya)[8]) {
    const int sg = lane >> 3, ko = lane & 7;
    LAS float* base = lds0 + (c & 1) * (SC_CH * SC_STR) + (8 * lw + sg) * SC_STR + 8 * ko;
    float r[8], k[8], a[8], w[8], kk[8];
    up8(R.r, r); up8(R.k, k); up8(R.a, a);
    w[0] = h2f((unsigned short)R.w.x); w[1] = h2f((unsigned short)(R.w.x >> 16)); w[2] = h2f((unsigned short)R.w.y); w[3] = h2f((unsigned short)(R.w.y >> 16));
    w[4] = h2f((unsigned short)R.w.z); w[5] = h2f((unsigned short)(R.w.z >> 16)); w[6] = h2f((unsigned short)R.w.w); w[7] = h2f((unsigned short)(R.w.w >> 16));
    float ss = 0.f;
#pragma unroll
    for (int e = 0; e < 8; ++e) { kk[e] = k[e] * keyk[e]; ss += kk[e] * kk[e]; }
    const float rn = __builtin_amdgcn_rsqf(sum8(ss) + 1e-12f);
    f32x4 o0, o1;
#define PUT2(off, expr) do { _Pragma("unroll") for (int e = 0; e < 4; ++e) { { const int E = e; o0[e] = (expr); } { const int E = e + 4; o1[e] = (expr); } } \
        *(LAS f32x4*)(base + (off)) = o0; *(LAS f32x4*)(base + (off) + 4) = o1; } while (0)
    float c1 = 0.f, c2 = 0.f;
#pragma unroll
    for (int e = 0; e < 8; ++e) { const float nka = -(kk[e] * rn * a[e]), kr = k[e] * (1.0f + (a[e] - 1.0f) * keya[e]); c1 += kr * r[e]; c2 += nka * r[e]; }
    c1 = sum8(c1); c2 = sum8(c2);
    PUT2(0, kk[E] * rn); PUT2(64, w[E]); PUT2(128, -(kk[E] * rn * a[E])); PUT2(192, k[E] * (1.0f + (a[E] - 1.0f) * keya[E])); PUT2(256, w[E] * r[E]);
#undef PUT2
    if (ko == 2) { base[-16 + 336] = c1; base[-16 + 337] = c2; }
    if (ko < 2) { float v[8]; up8(R.v, v); *(LAS f32x4*)(base - 8 * ko + 320 + 8 * ko) = (f32x4){v[0], v[1], v[2], v[3]}; *(LAS f32x4*)(base - 8 * ko + 320 + 8 * ko + 4) = (f32x4){v[4], v[5], v[6], v[7]}; }
}
typedef float f32x2s __attribute__((ext_vector_type(2)));
struct ScanOps { f32x4 kk, w, ka, kr, r; float v; f32x2s c; };
#define SC_ISSUE(O, A128, A32, AC, OFF) asm volatile("ds_read_b128 %0, %7 offset:%10\n\tds_read_b128 %1, %7 offset:%11\n\tds_read_b128 %2, %7 offset:%12\n\tds_read_b128 %3, %7 offset:%13\n\tds_read_b128 %4, %7 offset:%14\n\tds_read_b32 %5, %8 offset:%10\n\tds_read_b64 %6, %9 offset:%10" \
    : "=&v"(O.kk), "=&v"(O.w), "=&v"(O.ka), "=&v"(O.kr), "=&v"(O.r), "=&v"(O.v), "=&v"(O.c) : "v"(A128), "v"(A32), "v"(AC), "i"(OFF), "i"((OFF) + 256), "i"((OFF) + 512), "i"((OFF) + 768), "i"((OFF) + 1024) : "memory")
#define SC_LANDED(O) asm volatile("s_waitcnt lgkmcnt(0)" : "+v"(O.kk), "+v"(O.w), "+v"(O.ka), "+v"(O.kr), "+v"(O.r), "+v"(O.v), "+v"(O.c) :: "memory")
__device__ __forceinline__ float scan_step(f32x4& S, const ScanOps& C) {
    float d = S[0] * C.kk[0]; d = fmaf(S[1], C.kk[1], d); d = fmaf(S[2], C.kk[2], d); d = fmaf(S[3], C.kk[3], d);
    float q = S[0] * C.r[0]; q = fmaf(S[1], C.r[1], q); q = fmaf(S[2], C.r[2], q); q = fmaf(S[3], C.r[3], q);
    DPP_ROR_ADD(d, 8); DPP_ROR_ADD(q, 8); DPP_ROR_ADD(d, 4); DPP_ROR_ADD(q, 4); DPP_ROR_ADD(d, 2); DPP_ROR_ADD(q, 2); DPP_ROR_ADD(d, 1); DPP_ROR_ADD(q, 1);
    f32x4 T;
#pragma unroll
    for (int e = 0; e < 4; ++e) T[e] = fmaf(C.v, C.kr[e], S[e] * C.w[e]);
#pragma unroll
    for (int e = 0; e < 4; ++e) S[e] = fmaf(d, C.ka[e], T[e]);
    return fmaf(d, C.c[1], fmaf(C.v, C.c[0], q));
}
template <int XMODE> __device__ __forceinline__ void p_scan(int l) {
    KA A = kargs(); const Frame F = mk_frame(A);
    const bf16* RKV = (const bf16*)(F.ws + WS_RKV); const bf16* LO = (const bf16*)(F.ws + WS_LO); bf16* Y = (bf16*)(F.ws + WS_Y);
    const int lane = F.lane;
    LAS float* lds0 = (LAS float*)(F.lds);
    for (int task = lbid(); task < 256; task += F.G) {
        const int chain = task >> 2, rg = task & 3, b = chain >> 4, h = (chain >> 1) & 7, z = chain & 1;
        if (F.wave >= 4) {
            const int lw = F.wave - 4;
            float keyk[8], keya[8]; ldf8(A->in[I_KEYK] + l * 512 + h * 64 + 8 * (lane & 7), keyk); ldf8(A->in[I_KEYA] + l * 512 + h * 64 + 8 * (lane & 7), keya);
            ScanRaw RA, RB;
            if (XMODE == 1) { for (int c = 0; c < SC_NC + 1; ++c) SC_BAR(); continue; }
            scan_ldraw(RA, 0, lw, lane, b, h, z, rg, RKV, LO); scan_ldraw(RB, 1, lw, lane, b, h, z, rg, RKV, LO);
            scan_put(RA, 0, lw, lane, lds0, keyk, keya);
            scan_ldraw(RA, 2, lw, lane, b, h, z, rg, RKV, LO);
            SC_BAR();
#pragma unroll 1
            for (int c = 0; c < SC_NC; c += 2) {
                scan_put(RB, c + 1, lw, lane, lds0, keyk, keya);
                if (c + 3 < SC_NC) scan_ldraw(RB, c + 3, lw, lane, b, h, z, rg, RKV, LO);
                SC_BAR();
                if (c + 2 < SC_NC) scan_put(RA, c + 2, lw, lane, lds0, keyk, keya);
                if (c + 4 < SC_NC) scan_ldraw(RA, c + 4, lw, lane, b, h, z, rg, RKV, LO);
                SC_BAR();
            }
        } else {
            const int r = lane >> 4, j = lane & 15, cw = F.wave, vi = 4 * cw + r;
            if (XMODE == 2) { for (int c = 0; c < SC_NC + 1; ++c) SC_BAR(); continue; }
            __builtin_amdgcn_s_setprio(3);
            f32x4 S = (f32x4){0.f, 0.f, 0.f, 0.f};
            bf16* yout = Y + ((size_t)z * MR + (size_t)b * TP) * 512 + h * 64 + 16 * rg + 4 * cw + r;
            SC_BAR();
#pragma unroll 1
            for (int c = 0; c < SC_NC; ++c) {
                const unsigned bufb = (unsigned)((c & 1) * (SC_CH * SC_STR * 4));
                asm volatile("s_nop 0");
                const unsigned a128 = bufb + 16u * (unsigned)j, a32 = bufb + 4u * (unsigned)(320 + vi), ac = bufb + 4u * 336u;
                ScanOps P, Qn; float yk0 = 0.f, yk1 = 0.f;
                SC_ISSUE(P, a128, a32, ac, 0); SC_LANDED(P);
#pragma unroll
                for (int ii = 0; ii < SC_CH; ii += 2) {
                    SC_ISSUE(Qn, a128, a32, ac, (ii + 1) * SC_STR * 4); __builtin_amdgcn_sched_barrier(0);
                    { const float y = scan_step(S, P); if (ii < 16) yk0 = (j == ii) ? y : yk0; else yk1 = (j == ii - 16) ? y : yk1; }
                    asm volatile("" : "+v"(S)); __builtin_amdgcn_sched_barrier(0); SC_LANDED(Qn);
                    if (ii + 2 < SC_CH) SC_ISSUE(P, a128, a32, ac, (ii + 2) * SC_STR * 4);
                    __builtin_amdgcn_sched_barrier(0);
                    { const float y = scan_step(S, Qn); if (ii + 1 < 16) yk0 = (j == ii + 1) ? y : yk0; else yk1 = (j == ii + 1 - 16) ? y : yk1; }
                    asm volatile("" : "+v"(S)); __builtin_amdgcn_sched_barrier(0);
                    if (ii + 2 < SC_CH) SC_LANDED(P);
                }
                yout[(size_t)scan_p(c * SC_CH + j, z) * 512] = (bf16)f2bf(yk0);
                yout[(size_t)scan_p(c * SC_CH + 16 + j, z) * 512] = (bf16)f2bf(yk1);
                SC_BAR();
            }
            __builtin_amdgcn_s_setprio(0);
        }
    }
    __syncthreads();
}

__device__ __forceinline__ void p_attn(char* lds, int l) {
    KA A = kargs(); const Frame F = mk_frame(A);
    const attn_body::bf16* Q = (const attn_body::bf16*)(F.ws + WS_Q); const attn_body::bf16* K = (const attn_body::bf16*)(F.ws + WS_KB); const attn_body::bf16* V = (const attn_body::bf16*)(F.ws + WS_VB);
    const int NU = 1024 + (l == 0 ? 32 : 0);
    for (int u = F.vcu; u < NU; u += F.G) {
        if (u < 1024) { const int i = u >> 8, v = u & 255, bh = v >> 3, s = v & 7, b = bh >> 3, h = bh & 7;
            const int qb = (i == 0) ? s : (i == 1) ? 15 - s : (i == 2) ? 16 + s : 31 - s;
            attn_body::attn_unit<8>((long)b * TP + TCX + 256 * qb, h, (long)b * TP, TP / 64, Q, K, V, (attn_body::bf16*)(F.ws + WS_YO) + 512, lds);
        } else { const int c = u - 1024, b = c >> 3, h = c & 7;
            attn_body::attn_unit<8>((long)b * TP, h, (long)b * TP, TCX / 64, Q, K, V, (attn_body::bf16*)(F.ws + WS_YO) + 512, lds); }
    }
}

constexpr int PH_PRO = 0, PH_PER_LAYER = 15, PH_FINAL = 1 + NLAYER * PH_PER_LAYER, NPH = PH_FINAL + 1;
enum { O_NORM1 = 0, O_INPROJ, O_PREPA, O_LORA, O_SCAN, O_ATTN, O_POST, O_MG1A, O_MG1B, O_MG2, O_NORM2, O_TOPK, O_GATHER, O_MUP, O_MDOWN };
__device__ __forceinline__ void ph_inproj(int l) { KA A = kargs(); const Frame F = mk_frame(A);
    pg8::Gemm g{(const bf16*)(F.ws + WS_H), (const bf16*)(F.ws + WS_WIN) + (size_t)l * UC * DM, MR, UC, DM, DM, DM}; pg8::StaticOrder S; S.init(MR, UC, F.G, lbid(), 0, DM);
    pg8::EpiStore E{(bf16*)(F.ws + WS_U), UC}; pg8::gemm_phase<pg8::EpiStore, pg8::StaticOrder, true, true>(F.lds + RING_OFF, g, S, E); }
__device__ __forceinline__ void ph_lora(int l) { KA A = kargs(); const Frame F = mk_frame(A);
    pg8::Gemm g{(const bf16*)(F.ws + WS_L), (const bf16*)(F.ws + WS_WLORA) + (size_t)l * LOC * LK, MR, LOC, LK, LK, LK}; pg8::LoraOrder S; S.init(MR, LOC, F.G, lbid(), 0, LK);
    pg8::EpiLora E{(bf16*)(F.ws + WS_LO), LOC, A->in[I_DW0] + l * 1024, A->in[I_A0] + l * 1024}; pg8::gemm_phase<pg8::EpiLora, pg8::LoraOrder, true, true>(F.lds + RING_OFF, g, S, E); }
__device__ __forceinline__ void ph_mg1(int l) { KA A = kargs(); const Frame F = mk_frame(A);
    pg8::Gemm g{(const bf16*)(F.ws + WS_YO), (const bf16*)(F.ws + WS_WBR) + (size_t)l * DM * DM, MR, DM, DM, DM, DM}; pg8::MergeOrder S; S.init(MR, DM, F.G, lbid(), l == NLAYER - 1, DM);
    pg8::EpiMergeK E{(const bf16*)(F.ws + WS_U) + U_GR, (const bf16*)(F.ws + WS_U) + U_GA, UC, (bf16*)(F.ws + WS_M1)}; pg8::gemm_phase<pg8::EpiMergeK, pg8::MergeOrder, true, true>(F.lds + RING_OFF, g, S, E); }
__device__ __forceinline__ void ph_mg2(int l) { KA A = kargs(); const Frame F = mk_frame(A);
    pg8::Gemm g{(const bf16*)(F.ws + WS_M1), (const bf16*)(F.ws + WS_WOUT) + (size_t)l * DM * DM, MR, DM, DM, DM, DM}; pg8::StaticOrder S; S.init(MR, DM, F.G, lbid(), l == NLAYER - 1, DM);
    pg8::EpiResid E{(float*)(F.ws + WS_X), (const float*)(F.ws + WS_MODV) + (size_t)l * 5 * 6144}; pg8::gemm_phase<pg8::EpiResid, pg8::StaticOrder, true, true>(F.lds + RING_OFF, g, S, E); }
__device__ __forceinline__ void ph_mup(int l) { KA A = kargs(); const Frame F = mk_frame(A); const int nM = (l == 0) ? SLOT_ALL / 256 : SLOT_L / 256;
    pg8::Gemm g{(const bf16*)(F.ws + WS_H), (const bf16*)(F.ws + WS_WGU), nM * 256, 2 * FF, DM, DM, DM}; pg8::MoeOrderT<true> S; S.idx = (const int*)(F.ws + WS_IDX); S.init(nM, 2 * FF / 256, F.G, lbid(), DM);
    pg8::EpiMoeUp E{(bf16*)(F.ws + WS_HID), FF}; pg8::gemm_phase<pg8::EpiMoeUp, pg8::MoeOrderT<true>, true, true>(F.lds + RING_OFF, g, S, E); }
__device__ __forceinline__ void ph_mdown(int l) { KA A = kargs(); const Frame F = mk_frame(A); const int nM = (l == 0) ? SLOT_ALL / 256 : SLOT_L / 256;
    pg8::Gemm g{(const bf16*)(F.ws + WS_HID), (const bf16*)(F.ws + WS_WD), nM * 256, DM, FF, FF, FF}; pg8::MoeOrderT<false> S; S.idx = nullptr; S.init(nM, DM / 256, F.G, lbid(), FF);
    pg8::EpiMoeDown E{(bf16*)(F.ws + WS_XE), (const float*)(F.ws + WS_GATEV)}; pg8::gemm_phase<pg8::EpiMoeDown, pg8::MoeOrderT<false>, true, true>(F.lds + RING_OFF, g, S, E); }

__global__ void __launch_bounds__(NWAVES * 64, 2) fwd(Args args) {
    extern __shared__ __attribute__((aligned(16))) unsigned char lds[];
    {   LAS unsigned char* l3 = (LAS unsigned char*)lds;
        for (int u = threadIdx.x; u < (LDS_BYTES - LDSCTL_OFF) / 4; u += NWAVES * 64) ((LAS unsigned*)(l3 + LDSCTL_OFF))[u] = 0u; }
    __syncthreads();
    const int lo = args.ph_lo, hi = args.ph_hi, use_bar = args.use_bar;
    XcdBarrier bar; bar.bar = (unsigned*)(args.ws + WS_CTL) + CW_BAR; bar.x = 0; bar.st = nullptr;
    if (use_bar) bar = xcd_barrier_post((unsigned*)(args.ws + WS_CTL) + CW_BAR, (volatile LAS unsigned*)((LAS unsigned char*)lds + MISC_OFF) + 8);
#define IN(k) (lo <= (k) && (k) < hi)
#define SEAM(k) do { if (IN(k) && IN((k) + 1) && use_bar) xcd_barrier(bar); STAMP(k); } while (0)
#define STAMP(k) do { if (PROBE_MASK != 0ull && blockIdx.x == 0 && threadIdx.x == 0) { volatile LAS unsigned long long* pw = (volatile LAS unsigned long long*)((LAS unsigned char*)lds + MISC_OFF + 64); \
        const unsigned long long now = __builtin_amdgcn_s_memrealtime(); if ((PROBE_MASK >> (k)) & 1ull) pw[1] += now - pw[0]; pw[0] = now; } } while (0)
    if (PROBE_MASK != 0ull && blockIdx.x == 0 && threadIdx.x == 0) { volatile LAS unsigned long long* pw = (volatile LAS unsigned long long*)((LAS unsigned char*)lds + MISC_OFF + 64); pw[0] = __builtin_amdgcn_s_memrealtime(); pw[1] = 0ull; }
    if (IN(PH_PRO)) { p_prologue(); }
    SEAM(PH_PRO);
#pragma unroll 1
    for (int l = 0; l < NLAYER; ++l) {
        const int pb = 1 + l * PH_PER_LAYER;
        if (IN(pb + O_NORM1)) { if (l == 0) p_rownorm<0>(); else {
            const int wv = __builtin_amdgcn_readfirstlane(ltid() >> 6);
#pragma unroll 1
            for (int step = 0; step < 2; ++step) { if ((step ^ wv) & 1) { KA A = kargs(); const Frame F = mk_frame(A); cvt_moe(F, A, 1); } else p_rownorm<1>(); } } }
        SEAM(pb + O_NORM1);
        if (IN(pb + O_INPROJ)) ph_inproj(l);
        SEAM(pb + O_INPROJ);
        if (IN(pb + O_PREPA)) p_prep_a(l);
        SEAM(pb + O_PREPA);
        if (IN(pb + O_LORA)) ph_lora(l);
        SEAM(pb + O_LORA);
#ifdef SCAN_XMODE
        if (IN(pb + O_SCAN)) p_scan<SCAN_XMODE>(l);
#endif
        if (IN(pb + O_SCAN)) p_scan<0>(l);
        STAMP(pb + O_SCAN);
        if (IN(pb + O_ATTN)) p_attn((char*)lds + RING_OFF, l);
        SEAM(pb + O_ATTN);
        if (IN(pb + O_POST)) p_post(l);
        SEAM(pb + O_POST);
        if (IN(pb + O_MG1A)) ph_mg1(l);
        STAMP(pb + O_MG1A);
        SEAM(pb + O_MG1B);
        if (IN(pb + O_MG2)) ph_mg2(l);
        SEAM(pb + O_MG2);
        if (IN(pb + O_NORM2)) p_norm2(l);
        SEAM(pb + O_NORM2);
        if (IN(pb + O_TOPK)) p_topk(l);
        SEAM(pb + O_TOPK);
        STAMP(pb + O_GATHER);
        if (IN(pb + O_MUP)) ph_mup(l);
        SEAM(pb + O_MUP);
        if (IN(pb + O_MDOWN)) ph_mdown(l);
        SEAM(pb + O_MDOWN);
    }
    if (IN(PH_FINAL)) { p_rownorm<2>(); }
    STAMP(PH_FINAL);
    if (PROBE_MASK != 0ull && blockIdx.x == 0 && threadIdx.x == 0) { volatile LAS unsigned long long* pw = (volatile LAS unsigned long long*)((LAS unsigned char*)lds + MISC_OFF + 64);
        const unsigned long long t0 = pw[0], d = pw[1]; while (__builtin_amdgcn_s_memrealtime() - t0 < d) __builtin_amdgcn_s_sleep(8); }
#undef IN
#undef SEAM
#undef STAMP
}

extern "C" void kernel_launch(void* const* d_in, const int* in_sizes, int n_in, void* d_out, int out_size, void* d_ws, size_t ws_size, hipStream_t stream) {
    static int grid = 0;
    if (grid == 0) {
        if (n_in != 30 || out_size != NB * TL * DM || ws_size < WS_END) { fprintf(stderr, "kernel_launch: unexpected problem (n_in %d, out %d, ws %zu < %zu)\n", n_in, out_size, ws_size, (size_t)WS_END); grid = -1; return; }
        int dev = 0, cus = 0, per_cu = 0;
        if (hipGetDevice(&dev) != hipSuccess || hipDeviceGetAttribute(&cus, hipDeviceAttributeMultiprocessorCount, dev) != hipSuccess) { grid = -1; return; }
        if (hipFuncSetAttribute((const void*)fwd, hipFuncAttributeMaxDynamicSharedMemorySize, LDS_BYTES) != hipSuccess) { fprintf(stderr, "kernel_launch: hipFuncSetAttribute failed\n"); grid = -1; return; }
        if (hipOccupancyMaxActiveBlocksPerMultiprocessor(&per_cu, (const void*)fwd, NWAVES * 64, LDS_BYTES) != hipSuccess || per_cu < 1) fprintf(stderr, "kernel_launch: occupancy query reports %d\n", per_cu);
        (void)hipGetLastError();
        grid = cus;
    }
    if (grid < 0) return;
    if (hipMemsetAsync((char*)d_ws + WS_CTL, 0, CTL_ZERO_BYTES, stream) != hipSuccess) return;
    Args a{};
    for (int i = 0; i < 30; ++i) a.in[i] = (const float*)d_in[i];
    a.out = (float*)d_out; a.ws = (unsigned char*)d_ws; a.pad = 0;
#if MK_PER_PHASE
    for (int ph = 0; ph < NPH; ++ph) { a.ph_lo = ph; a.ph_hi = ph + 1; a.use_bar = 0;
        hipLaunchKernelGGL(fwd, dim3(grid), dim3(NWAVES * 64), LDS_BYTES, stream, a); }
#else
    a.ph_lo = 0; a.ph_hi = NPH; a.use_bar = 1;
    hipLaunchKernelGGL(fwd, dim3(grid), dim3(NWAVES * 64), LDS_BYTES, stream, a);
#endif
}
```

```cpp
#include <hip/hip_runtime.h>
#include <hip/hip_bf16.h>
#include <cstdio>
#include <cstdint>
#include <cmath>

#ifndef PROBE_MASK
#define PROBE_MASK 0ull
#endif
#ifndef MK_PER_PHASE
#define MK_PER_PHASE 0
#endif

__device__ __forceinline__ int ltid() { int t = threadIdx.x; asm volatile("" : "+v"(t)); return t; }
__device__ __forceinline__ int lbid() { int b = blockIdx.x; asm volatile("" : "+s"(b)); return b; }
namespace pg8 {
#define PG8_LAS __attribute__((address_space(3)))
typedef unsigned short bf16_t;
typedef short bf16x8 __attribute__((ext_vector_type(8)));
typedef float f32x4 __attribute__((ext_vector_type(4)));
typedef unsigned u32x4 __attribute__((ext_vector_type(4)));
constexpr int BM = 256, BK = 64, HALF = 128, HTB = HALF * BK * 2  , STAGE_BYTES = 8 * HTB, NXCD = 8, WGM = 8;

__host__ __device__ __forceinline__ int lds_byte(int r, int c) { const int st = (r >> 4) * 2 + (c >> 5), rr = r & 15, cc = c & 31, ob = rr * 64 + cc * 2; return st * 1024 + (ob ^ (((ob >> 9) & 1) << 5)); }
__host__ __device__ __forceinline__ void stage_rc(int b, int& R, int& C) { const int st = b / 1024, sb = b % 1024, swz = sb ^ (((sb >> 9) & 1) << 5); R = (st >> 1) * 16 + swz / 64; C = (st & 1) * 32 + (swz % 64) / 2; }
__host__ __device__ __forceinline__ int perm32(int rho) { const int n = rho >> 4, i = rho & 15; return 8 * (i >> 2) + 4 * n + (i & 3); }

struct Unit { int pm, pn, pb, k0, nt, cont; };
struct Gemm { const bf16_t* A; const bf16_t* Bt; int M, N, K, lda, ldb; };

struct StaticOrder {
    static constexpr bool GATHER = false; __device__ __forceinline__ int arow(int r) const { return r; }
    int nM, nN, nwg, G, c, skip, ntk;
    __host__ __device__ void init(int M, int N, int G_, int c_, int skip_ = 0, int K_ = 0) { ntk = K_ / BK; skip = skip_; nM = M / BM - (skip_ ? 4 : 0); nN = N / BM; nwg = nM * nN; G = G_; c = c_; }
    __host__ __device__ bool next(int i, Unit& u) const {
        const long L = (long)i * G + c; if (L >= nwg) return false;
        int wgid = (int)L; { const int q = nwg / NXCD, r = nwg % NXCD, xcd = wgid % NXCD, off = wgid / NXCD; wgid = (xcd < r ? xcd * (q + 1) : r * (q + 1) + (xcd - r) * q) + off; }
        const int nig = WGM * nN, gid = wgid / nig, fm = gid * WGM, gsz = (nM - fm) < WGM ? (nM - fm) : WGM;
        u.pm = fm + ((wgid % nig) % gsz); u.pn = (wgid % nig) / gsz; u.pb = u.pn; u.k0 = 0; u.nt = ntk; u.cont = 0; if (skip) u.pm += (u.pm >> 5) + 1; return true;
    }
    __device__ __forceinline__ void a_ready(const Unit&) const {}
    __device__ __forceinline__ void done(const Unit&) const {}
};

__device__ __forceinline__ unsigned cvt_pk_bf16(float lo, float hi) { unsigned r; asm volatile("v_cvt_pk_bf16_f32 %0, %1, %2" : "=v"(r) : "v"(lo), "v"(hi)); return r; }
__device__ __forceinline__ float bf_lo(unsigned u) { return __uint_as_float(u << 16); }
__device__ __forceinline__ float bf_hi(unsigned u) { return __uint_as_float(u & 0xffff0000u); }
__device__ __forceinline__ float fsigmoid(float x) { return __builtin_amdgcn_rcpf(1.0f + __expf(-x)); }
__device__ __forceinline__ unsigned pk_f16(float lo, float hi) { const _Float16 a = (_Float16)lo, b = (_Float16)hi; return (unsigned)__builtin_bit_cast(unsigned short, a) | ((unsigned)__builtin_bit_cast(unsigned short, b) << 16); }

struct EpiStore {
    static constexpr bool PERM = true, AFTER_DRAIN = false;
    bf16_t* O; int ldc;
    __device__ __forceinline__ void operator()(const f32x4 (&acc)[2][2][4][2], const Unit& u, int wr, int wc, int fr, int fq) const {
        const int row0 = u.pm * BM + wr * 64 + fr, col0 = u.pn * BM + wc * 32 + 8 * fq;
#pragma unroll
        for (int ai = 0; ai < 2; ++ai)
#pragma unroll
            for (int m = 0; m < 4; ++m) { bf16_t* rowp = O + (size_t)(row0 + ai * HALF + m * 16) * ldc + col0;
#pragma unroll
                for (int bj = 0; bj < 2; ++bj) { const f32x4 v0 = acc[ai][bj][m][0], v1 = acc[ai][bj][m][1];
                    u32x4 w; w.x = cvt_pk_bf16(v0[0], v0[1]); w.y = cvt_pk_bf16(v0[2], v0[3]); w.z = cvt_pk_bf16(v1[0], v1[1]); w.w = cvt_pk_bf16(v1[2], v1[3]);
                    *(u32x4*)(rowp + bj * HALF) = w; } }
    }
};
struct EpiLora {
    static constexpr bool PERM = true, AFTER_DRAIN = false;
    bf16_t* O; int ldc; const float* w0; const float* a0;
    __device__ __forceinline__ void operator()(const f32x4 (&acc)[2][2][4][2], const Unit& u, int wr, int wc, int fr, int fq) const {
        const int row0 = u.pm * BM + wr * 64 + fr, col0 = u.pn * BM + wc * 32 + 8 * fq;
        const int typ = u.pn < 2 ? 0 : (u.pn < 6 ? 1 : 2);
        f32x4 bv[2][2];
#pragma unroll
        for (int bj = 0; bj < 2; ++bj)
#pragma unroll
            for (int n = 0; n < 2; ++n) { const int c = col0 + bj * HALF + 4 * n;
                bv[bj][n] = typ == 0 ? (f32x4){0.f, 0.f, 0.f, 0.f} : (typ == 1 ? *(const f32x4*)(w0 + (c - 512)) : *(const f32x4*)(a0 + (c - 1536))); }
#pragma unroll
        for (int ai = 0; ai < 2; ++ai)
#pragma unroll
            for (int m = 0; m < 4; ++m) { bf16_t* rowp = O + (size_t)(row0 + ai * HALF + m * 16) * ldc + col0;
#pragma unroll
                for (int bj = 0; bj < 2; ++bj) { f32x4 v0 = acc[ai][bj][m][0] + bv[bj][0], v1 = acc[ai][bj][m][1] + bv[bj][1]; u32x4 w;
                    if (typ == 1) {
#pragma unroll
                        for (int i = 0; i < 4; ++i) { v0[i] = __expf(-0.6065306597126334f * fsigmoid(v0[i])); v1[i] = __expf(-0.6065306597126334f * fsigmoid(v1[i])); }
                        w.x = pk_f16(v0[0], v0[1]); w.y = pk_f16(v0[2], v0[3]); w.z = pk_f16(v1[0], v1[1]); w.w = pk_f16(v1[2], v1[3]);
                    } else {
                        if (typ == 2) {
#pragma unroll
                            for (int i = 0; i < 4; ++i) { v0[i] = fsigmoid(v0[i]); v1[i] = fsigmoid(v1[i]); } }
                        w.x = cvt_pk_bf16(v0[0], v0[1]); w.y = cvt_pk_bf16(v0[2], v0[3]); w.z = cvt_pk_bf16(v1[0], v1[1]); w.w = cvt_pk_bf16(v1[2], v1[3]);
                    }
                    *(u32x4*)(rowp + bj * HALF) = w; } }
    }
};
struct EpiMergeK {
    static constexpr bool PERM = true, AFTER_DRAIN = false;
    const bf16_t* GR; const bf16_t* GA; int ldg; bf16_t* M1;
    __device__ __forceinline__ void operator()(f32x4 (&acc)[2][2][4][2], const Unit& u, int wr, int wc, int fr, int fq) const {
        const int row0 = u.pm * BM + wr * 64 + fr, col0 = u.pn * BM + wc * 32 + 8 * fq;
        if (!u.cont) {
#pragma unroll
            for (int ai = 0; ai < 2; ++ai)
#pragma unroll
                for (int m = 0; m < 4; ++m) { const size_t row = (size_t)(row0 + ai * HALF + m * 16);
#pragma unroll
                    for (int bj = 0; bj < 2; ++bj) { const int c = col0 + bj * HALF;
                        const u32x4 rw = *(const u32x4*)(GR + row * ldg + c), aw = *(const u32x4*)(GA + row * ldg + c);
                        f32x4 s0, s1;
                        s0[0] = (1.0f + __expf(-bf_lo(aw.x))) * __builtin_amdgcn_rcpf(1.0f + __expf(-bf_lo(rw.x))); s0[1] = (1.0f + __expf(-bf_hi(aw.x))) * __builtin_amdgcn_rcpf(1.0f + __expf(-bf_hi(rw.x)));
                        s0[2] = (1.0f + __expf(-bf_lo(aw.y))) * __builtin_amdgcn_rcpf(1.0f + __expf(-bf_lo(rw.y))); s0[3] = (1.0f + __expf(-bf_hi(aw.y))) * __builtin_amdgcn_rcpf(1.0f + __expf(-bf_hi(rw.y)));
                        s1[0] = (1.0f + __expf(-bf_lo(aw.z))) * __builtin_amdgcn_rcpf(1.0f + __expf(-bf_lo(rw.z))); s1[1] = (1.0f + __expf(-bf_hi(aw.z))) * __builtin_amdgcn_rcpf(1.0f + __expf(-bf_hi(rw.z)));
                        s1[2] = (1.0f + __expf(-bf_lo(aw.w))) * __builtin_amdgcn_rcpf(1.0f + __expf(-bf_lo(rw.w))); s1[3] = (1.0f + __expf(-bf_hi(aw.w))) * __builtin_amdgcn_rcpf(1.0f + __expf(-bf_hi(rw.w)));
                        acc[ai][bj][m][0] *= s0; acc[ai][bj][m][1] *= s1; }
                    if (m & 1) asm volatile("" ::: "memory"); }
        } else {
#pragma unroll
            for (int ai = 0; ai < 2; ++ai)
#pragma unroll
                for (int m = 0; m < 4; ++m) { const size_t row = (size_t)(row0 + ai * HALF + m * 16);
#pragma unroll
                    for (int bj = 0; bj < 2; ++bj) { const int c = col0 + bj * HALF;
                        const u32x4 gw = *(const u32x4*)(GA + row * ldg + c);
                        f32x4 g0, g1; g0[0] = fsigmoid(bf_lo(gw.x)); g0[1] = fsigmoid(bf_hi(gw.x)); g0[2] = fsigmoid(bf_lo(gw.y)); g0[3] = fsigmoid(bf_hi(gw.y));
                        g1[0] = fsigmoid(bf_lo(gw.z)); g1[1] = fsigmoid(bf_hi(gw.z)); g1[2] = fsigmoid(bf_lo(gw.w)); g1[3] = fsigmoid(bf_hi(gw.w));
                        const f32x4 v0 = acc[ai][bj][m][0] * g0, v1 = acc[ai][bj][m][1] * g1;
                        u32x4 w; w.x = cvt_pk_bf16(v0[0], v0[1]); w.y = cvt_pk_bf16(v0[2], v0[3]); w.z = cvt_pk_bf16(v1[0], v1[1]); w.w = cvt_pk_bf16(v1[2], v1[3]);
                        *(u32x4*)(M1 + row * 1024 + c) = w; } }
        }
    }
};
struct EpiResid {
    static constexpr bool PERM = true, AFTER_DRAIN = false;
    float* X; const float* modl;
    __device__ __forceinline__ void operator()(const f32x4 (&acc)[2][2][4][2], const Unit& u, int wr, int wc, int fr, int fq) const {
        const int row0 = u.pm * BM + wr * 64 + fr, col0 = u.pn * BM + wc * 32 + 8 * fq;
        const int sel = (u.pm % 33 == 0) ? 4 : (u.pm / 33);
        const float* gt = modl + sel * 6144 + 2048;
#pragma unroll
        for (int bj = 0; bj < 2; ++bj) { const int c = col0 + bj * HALF; const f32x4 t0 = *(const f32x4*)(gt + c), t1 = *(const f32x4*)(gt + c + 4);
#pragma unroll
            for (int ai = 0; ai < 2; ++ai)
#pragma unroll
                for (int m = 0; m < 4; ++m) { float* xp = X + (size_t)(row0 + ai * HALF + m * 16) * 1024 + c;
                    const f32x4 x0 = *(const f32x4*)xp, x1 = *(const f32x4*)(xp + 4);
                    *(f32x4*)xp = x0 + t0 * acc[ai][bj][m][0]; *(f32x4*)(xp + 4) = x1 + t1 * acc[ai][bj][m][1]; } }
    }
};
struct EpiMoeUp {
    static constexpr bool PERM = true, AFTER_DRAIN = false;
    bf16_t* HID; int ldc;
    __device__ __forceinline__ void operator()(const f32x4 (&acc)[2][2][4][2], const Unit& u, int wr, int wc, int fr, int fq) const {
        const int row0 = u.pm * BM + wr * 64 + fr, col0 = u.pn * HALF + wc * 32 + 8 * fq;
#pragma unroll
        for (int ai = 0; ai < 2; ++ai)
#pragma unroll
            for (int m = 0; m < 4; ++m) { bf16_t* rowp = HID + (size_t)(row0 + ai * HALF + m * 16) * ldc + col0;
                f32x4 h0, h1;
#pragma unroll
                for (int i = 0; i < 4; ++i) { const float g0 = acc[ai][0][m][0][i], g1 = acc[ai][0][m][1][i];
                    h0[i] = g0 * fsigmoid(g0) * acc[ai][1][m][0][i]; h1[i] = g1 * fsigmoid(g1) * acc[ai][1][m][1][i]; }
                u32x4 w; w.x = cvt_pk_bf16(h0[0], h0[1]); w.y = cvt_pk_bf16(h0[2], h0[3]); w.z = cvt_pk_bf16(h1[0], h1[1]); w.w = cvt_pk_bf16(h1[2], h1[3]);
                *(u32x4*)rowp = w; }
    }
};
struct EpiMoeDown {
    static constexpr bool PERM = true, AFTER_DRAIN = false;
    bf16_t* YE; const float* gatev;
    __device__ __forceinline__ void operator()(const f32x4 (&acc)[2][2][4][2], const Unit& u, int wr, int wc, int fr, int fq) const {
        const int row0 = u.pm * BM + wr * 64 + fr, col0 = u.pn * BM + wc * 32 + 8 * fq;
#pragma unroll
        for (int ai = 0; ai < 2; ++ai)
#pragma unroll
            for (int m = 0; m < 4; ++m) { const size_t row = (size_t)(row0 + ai * HALF + m * 16); const float gv = gatev[row]; bf16_t* rowp = YE + row * 1024 + col0;
#pragma unroll
                for (int bj = 0; bj < 2; ++bj) { const f32x4 v0 = acc[ai][bj][m][0] * gv, v1 = acc[ai][bj][m][1] * gv;
                    u32x4 w; w.x = cvt_pk_bf16(v0[0], v0[1]); w.y = cvt_pk_bf16(v0[2], v0[3]); w.z = cvt_pk_bf16(v1[0], v1[1]); w.w = cvt_pk_bf16(v1[2], v1[3]);
                    *(u32x4*)(rowp + bj * HALF) = w; } }
    }
};
struct LoraOrder : StaticOrder {
    __host__ __device__ bool next(int i, Unit& u) const { if (!StaticOrder::next(i, u)) return false;
        if (u.pn < 2) { u.k0 = 0; u.nt = 4; } else { u.k0 = 256 + 128 * ((u.pn - 2) >> 1); u.nt = 2; } return true; }
};
struct MergeOrder : StaticOrder {
    __host__ __device__ bool next(int i, Unit& u) const { if (!StaticOrder::next(i >> 1, u)) return false; u.k0 = (i & 1) * 512; u.nt = 8; u.cont = i & 1; return true; }
};
template <bool GATH> struct MoeOrderT {
    static constexpr bool GATHER = GATH; const int* idx;
    __device__ __forceinline__ int arow(int r) const { const int v = idx[r]; return v < 0 ? 0 : v; }
    int nM, nN, nwg, G, c, ntk;
    __host__ __device__ void init(int nM_, int nN_, int G_, int c_, int K_) { ntk = K_ / BK; nM = nM_; nN = nN_; nwg = nM * nN; G = G_; c = c_; }
    __host__ __device__ bool next(int i, Unit& u) const {
        const long L = (long)i * G + c; if (L >= nwg) return false;
        int wgid = (int)L; { const int q = nwg / NXCD, r = nwg % NXCD, xcd = wgid % NXCD, off = wgid / NXCD; wgid = (xcd < r ? xcd * (q + 1) : r * (q + 1) + (xcd - r) * q) + off; }
        const int nig = WGM * nN, gid = wgid / nig, fm = gid * WGM, gsz = (nM - fm) < WGM ? (nM - fm) : WGM;
        u.pm = fm + ((wgid % nig) % gsz); u.pn = (wgid % nig) / gsz;
        const int e = u.pm < 256 ? (u.pm >> 4) : (u.pm - 256); u.pb = e * nN + u.pn; u.k0 = 0; u.nt = ntk; u.cont = 0; return true;
    }
    __device__ __forceinline__ void a_ready(const Unit&) const {}
    __device__ __forceinline__ void done(const Unit&) const {}
};

template <class Epi, class Sched, bool ALIGN_EPI = false, bool SP2 = false>
__device__ __forceinline__ void gemm_phase(PG8_LAS unsigned char* lds, const Gemm g, const Sched& S, const Epi& E) {
    const int tid = ltid(), wid = __builtin_amdgcn_readfirstlane(tid >> 6), lane = tid & 63, wr = wid >> 2, wc = wid & 3, fr = lane & 15, fq = lane >> 4;
    const int lda = g.lda, ldb = g.ldb;
    unsigned voffA[2], voffB[2]; int rowA[2]; unsigned colA[2];
#pragma unroll
    for (int i = 0; i < 2; ++i) { int R, C; stage_rc(tid * 16 + i * 8192, R, C); const int Rb = Epi::PERM ? ((R & ~31) + perm32(R & 31)) : R;
        voffA[i] = (unsigned)(R * lda + C) * 2u; voffB[i] = (unsigned)(Rb * ldb + C) * 2u; rowA[i] = R; colA[i] = (unsigned)C * 2u; }
    const size_t kstep = (size_t)(BK * 2);
    const size_t hstepA = (size_t)HALF * lda * 2, hstepB = (size_t)HALF * ldb * 2;
    const size_t tstepA = 2 * hstepA, tstepB = 2 * hstepB;
    const unsigned ldsw = (unsigned)wid * 1024u;
    const int aoff = lds_byte(wr * 64 + fr, fq * 8), boff = lds_byte(wc * 32 + fr, fq * 8);
#define PG8_SA(b, h) (((b) * 2 + (h)) * HTB)
#define PG8_SB(b, h) ((4 + (b) * 2 + (h)) * HTB)
#define PG8_STAGE(bufoff, gbase, voff) do { _Pragma("unroll") for (int _i = 0; _i < 2; ++_i) \
        __builtin_amdgcn_global_load_lds((const unsigned*)((const char*)(gbase) + (voff)[_i]), (PG8_LAS unsigned*)(lds + (bufoff) + ldsw + _i * 8192), 16, 0, 0); } while (0)
#define PG8_STAGE_SEL(bufoff, gbase, sel, vA, vB) do { _Pragma("unroll") for (int _i = 0; _i < 2; ++_i) \
        __builtin_amdgcn_global_load_lds((const unsigned*)((const char*)(gbase) + ((sel) ? (vA)[_i] : (vB)[_i])), (PG8_LAS unsigned*)(lds + (bufoff) + ldsw + _i * 8192), 16, 0, 0); } while (0)
#define PG8_LDA(dst, b, h) do { _Pragma("unroll") for (int m = 0; m < 4; ++m) _Pragma("unroll") for (int k = 0; k < 2; ++k) dst[m][k] = *(const PG8_LAS bf16x8*)(lds + PG8_SA(b, h) + aoff + m * 2048 + k * 1024); } while (0)
#define PG8_LDB(dst, b, h) do { _Pragma("unroll") for (int n = 0; n < 2; ++n) _Pragma("unroll") for (int k = 0; k < 2; ++k) dst[n][k] = *(const PG8_LAS bf16x8*)(lds + PG8_SB(b, h) + boff + n * 2048 + k * 1024); } while (0)
#define PG8_MMA(ai, bj, At, Bt) do { __builtin_amdgcn_s_setprio(1); _Pragma("unroll") for (int m = 0; m < 4; ++m) _Pragma("unroll") for (int n = 0; n < 2; ++n) _Pragma("unroll") for (int k = 0; k < 2; ++k) \
        acc[ai][bj][m][n] = __builtin_amdgcn_mfma_f32_16x16x32_bf16(Bt[n][k], At[m][k], acc[ai][bj][m][n], 0, 0, 0); __builtin_amdgcn_s_setprio(0); } while (0)
#define PG8_WAIT_V(n) asm volatile("s_waitcnt vmcnt(" #n ")" ::: "memory")
#define PG8_WAIT_L(n) asm volatile("s_waitcnt lgkmcnt(" #n ")" ::: "memory")
#define PG8_BAR __builtin_amdgcn_s_barrier()
#define PG8_SCHED __builtin_amdgcn_sched_barrier(0)
    Unit cur, nxt; int ui = 0;
    if (!S.next(0, cur)) return;
    f32x4 acc[2][2][4][2];
#pragma unroll
    for (int a = 0; a < 2; ++a)
#pragma unroll
        for (int b = 0; b < 2; ++b)
#pragma unroll
            for (int m = 0; m < 4; ++m)
#pragma unroll
                for (int n = 0; n < 2; ++n) acc[a][b][m][n] = (f32x4){0.f, 0.f, 0.f, 0.f};
    bf16x8 At[4][2], B0[2][2], B1[2][2];
    unsigned vc0[2], vc1[2], vn0[2], vn1[2];
#define PG8_SETV(u_, o0, o1) do { _Pragma("unroll") for (int _i = 0; _i < 2; ++_i) { if constexpr (Sched::GATHER) { \
            o0[_i] = (unsigned)S.arow((u_).pm * BM + rowA[_i]) * (unsigned)(lda * 2) + colA[_i]; o1[_i] = (unsigned)S.arow((u_).pm * BM + HALF + rowA[_i]) * (unsigned)(lda * 2) + colA[_i]; } \
        else { o0[_i] = voffA[_i]; o1[_i] = voffA[_i] + (unsigned)hstepA; } } } while (0)
    PG8_SETV(cur, vc0, vc1);
#pragma unroll
    for (int _i = 0; _i < 2; ++_i) { vn0[_i] = vc0[_i]; vn1[_i] = vc1[_i]; }
    const char* cA = (const char*)g.A + (Sched::GATHER ? (size_t)0 : (size_t)cur.pm * tstepA) + (size_t)cur.k0 * 2; const char* cB = (const char*)g.Bt + (size_t)cur.pb * tstepB + (size_t)cur.k0 * 2;
    S.a_ready(cur);
    if constexpr (SP2) {
        PG8_STAGE(PG8_SB(0, 0), cB, voffB); PG8_STAGE(PG8_SB(0, 1), cB + hstepB, voffB); PG8_STAGE(PG8_SA(0, 0), cA, vc0); PG8_STAGE(PG8_SA(0, 1), cA, vc1);
        if (wr == 1) PG8_BAR;
        PG8_WAIT_V(2); PG8_BAR;
        PG8_STAGE(PG8_SB(1, 0), cB + kstep, voffB); PG8_STAGE(PG8_SA(1, 0), cA + kstep, vc0); PG8_STAGE(PG8_SB(1, 1), cB + hstepB + kstep, voffB);
        PG8_WAIT_V(6); PG8_BAR;
    } else {
        PG8_STAGE(PG8_SB(0, 0), cB, voffB); PG8_STAGE(PG8_SA(0, 0), cA, vc0); PG8_STAGE(PG8_SB(0, 1), cB + hstepB, voffB); PG8_STAGE(PG8_SA(0, 1), cA, vc1);
        if (wr == 1) PG8_BAR;
        PG8_WAIT_V(4); PG8_BAR;
        PG8_STAGE(PG8_SB(1, 0), cB + kstep, voffB); PG8_STAGE(PG8_SA(1, 0), cA + kstep, vc0); PG8_STAGE(PG8_SB(1, 1), cB + hstepB + kstep, voffB);
        PG8_WAIT_V(6); PG8_BAR;
    }
    for (;;) {
        const bool has_next = S.next(ui + 1, nxt);
        int rawn0 = 0, rawn1 = 0, rawn2 = 0, rawn3 = 0;
        if constexpr (Sched::GATHER) { if (has_next) {
            const int* ip0 = S.idx + nxt.pm * BM + rowA[0]; const int* ip1 = S.idx + nxt.pm * BM + rowA[1];
            asm volatile("global_load_dword %0, %4, off\n\tglobal_load_dword %1, %5, off\n\tglobal_load_dword %2, %4, off offset:512\n\tglobal_load_dword %3, %5, off offset:512"
                         : "=&v"(rawn0), "=&v"(rawn1), "=&v"(rawn2), "=&v"(rawn3) : "v"(ip0), "v"(ip1) : "memory"); } }
        else { if (has_next) PG8_SETV(nxt, vn0, vn1); }
        const char* nA = has_next ? (const char*)g.A + (Sched::GATHER ? (size_t)0 : (size_t)nxt.pm * tstepA) + (size_t)nxt.k0 * 2 : cA; const char* nB = has_next ? (const char*)g.Bt + (size_t)nxt.pb * tstepB + (size_t)nxt.k0 * 2 : cB;
        const int nt = cur.nt;
        for (int t = 0; t < nt; t += 2) {
            const bool last = (t == nt - 2);
            const char* a1 = cA + (size_t)(t + 1) * kstep;
            const char* a2 = last ? nA : cA + (size_t)(t + 2) * kstep; const char* b2 = last ? nB : cB + (size_t)(t + 2) * kstep;
            const char* a3 = a2 + kstep; const char* b3 = b2 + kstep;
            if (last && has_next) S.a_ready(nxt);
            if constexpr (Sched::GATHER) { if (last && has_next) {
                asm volatile("; gathered row indices of the next unit" : "+v"(rawn0), "+v"(rawn1), "+v"(rawn2), "+v"(rawn3));
                vn0[0] = (unsigned)(rawn0 < 0 ? 0 : rawn0) * (unsigned)(lda * 2) + colA[0]; vn0[1] = (unsigned)(rawn1 < 0 ? 0 : rawn1) * (unsigned)(lda * 2) + colA[1];
                vn1[0] = (unsigned)(rawn2 < 0 ? 0 : rawn2) * (unsigned)(lda * 2) + colA[0]; vn1[1] = (unsigned)(rawn3 < 0 ? 0 : rawn3) * (unsigned)(lda * 2) + colA[1]; } }
            if constexpr (SP2) {
            PG8_LDB(B0, 0, 0); PG8_LDB(B1, 0, 1); PG8_SCHED; PG8_LDA(At, 0, 0); PG8_STAGE(PG8_SA(1, 1), a1, vc1);
            PG8_WAIT_V(8); PG8_WAIT_L(0); PG8_BAR; PG8_MMA(0, 0, At, B0); PG8_MMA(0, 1, At, B1); PG8_BAR; PG8_SCHED;
            PG8_LDA(At, 0, 1); PG8_STAGE(PG8_SB(0, 0), b2, voffB); PG8_STAGE(PG8_SB(0, 1), b2 + hstepB, voffB); PG8_STAGE_SEL(PG8_SA(0, 0), a2, last, vn0, vc0);
            PG8_WAIT_V(8); PG8_WAIT_L(0); PG8_BAR; PG8_MMA(1, 0, At, B0); PG8_MMA(1, 1, At, B1); PG8_BAR; PG8_SCHED;
            PG8_LDB(B0, 1, 0); PG8_LDB(B1, 1, 1); PG8_SCHED; PG8_LDA(At, 1, 0); PG8_STAGE_SEL(PG8_SA(0, 1), a2, last, vn1, vc1);
            PG8_WAIT_V(8); PG8_WAIT_L(0); PG8_BAR; PG8_MMA(0, 0, At, B0); PG8_MMA(0, 1, At, B1); PG8_BAR; PG8_SCHED;
            PG8_LDA(At, 1, 1); PG8_STAGE(PG8_SB(1, 0), b3, voffB); PG8_STAGE(PG8_SB(1, 1), b3 + hstepB, voffB); PG8_STAGE_SEL(PG8_SA(1, 0), a3, last, vn0, vc0);
            PG8_WAIT_V(8); PG8_WAIT_L(0); PG8_BAR; PG8_MMA(1, 0, At, B0); PG8_MMA(1, 1, At, B1); PG8_BAR; PG8_SCHED;
            } else {
            PG8_LDB(B0, 0, 0); PG8_SCHED; PG8_LDA(At, 0, 0); PG8_STAGE(PG8_SA(1, 1), a1, vc1);
            PG8_WAIT_L(8); PG8_BAR; PG8_WAIT_L(0); PG8_MMA(0, 0, At, B0); PG8_BAR; PG8_SCHED;
            PG8_LDB(B1, 0, 1); PG8_STAGE(PG8_SB(0, 0), b2, voffB);
            PG8_BAR; PG8_WAIT_L(0); PG8_MMA(0, 1, At, B1); PG8_BAR;
            PG8_LDA(At, 0, 1); PG8_STAGE_SEL(PG8_SA(0, 0), a2, last, vn0, vc0);
            PG8_BAR; PG8_WAIT_L(0); PG8_MMA(1, 0, At, B0); PG8_BAR; PG8_SCHED;
            PG8_STAGE(PG8_SB(0, 1), b2 + hstepB, voffB);
            PG8_WAIT_V(6); PG8_BAR; PG8_MMA(1, 1, At, B1); PG8_BAR;
            PG8_LDB(B0, 1, 0); PG8_SCHED; PG8_LDA(At, 1, 0); PG8_STAGE_SEL(PG8_SA(0, 1), a2, last, vn1, vc1);
            PG8_WAIT_L(8); PG8_BAR; PG8_WAIT_L(0); PG8_MMA(0, 0, At, B0); PG8_BAR; PG8_SCHED;
            PG8_LDB(B1, 1, 1); PG8_STAGE(PG8_SB(1, 0), b3, voffB);
            PG8_BAR; PG8_WAIT_L(0); PG8_MMA(0, 1, At, B1); PG8_BAR;
            PG8_LDA(At, 1, 1); PG8_STAGE_SEL(PG8_SA(1, 0), a3, last, vn0, vc0);
            PG8_BAR; PG8_WAIT_L(0); PG8_MMA(1, 0, At, B0); PG8_BAR; PG8_SCHED;
            PG8_STAGE(PG8_SB(1, 1), b3 + hstepB, voffB);
            PG8_WAIT_V(6); PG8_BAR; PG8_MMA(1, 1, At, B1); PG8_BAR;
            }
        }
        if constexpr (ALIGN_EPI) { if (wr == 0) PG8_BAR; }
        if constexpr (!Epi::AFTER_DRAIN) { E(acc, cur, wr, wc, fr, fq); S.done(cur); }
        if (!has_next) break;
        if (!nxt.cont)
#pragma unroll
        for (int a = 0; a < 2; ++a)
#pragma unroll
            for (int b = 0; b < 2; ++b)
#pragma unroll
                for (int m = 0; m < 4; ++m)
#pragma unroll
                    for (int n = 0; n < 2; ++n) acc[a][b][m][n] = (f32x4){0.f, 0.f, 0.f, 0.f};
        cur = nxt; cA = nA; cB = nB; ++ui;
#pragma unroll
        for (int _i = 0; _i < 2; ++_i) { vc0[_i] = vn0[_i]; vc1[_i] = vn1[_i]; }
        if constexpr (ALIGN_EPI) { if (wr == 1) PG8_BAR; }
    }
    PG8_WAIT_V(0);
    if constexpr (!ALIGN_EPI) { if (wr == 0) PG8_BAR; }
    PG8_BAR;
    if constexpr (Epi::AFTER_DRAIN) { E.fused(acc, cur, wr, wc, fr, fq, lds, wid, lane); S.done(cur); }
#undef PG8_SETV
#undef PG8_SA
#undef PG8_SB
#undef PG8_STAGE
#undef PG8_STAGE_SEL
#undef PG8_LDA
#undef PG8_LDB
#undef PG8_MMA
#undef PG8_WAIT_V
#undef PG8_WAIT_L
#undef PG8_BAR
#undef PG8_SCHED
}
}

namespace attn_body {
using bf16=__hip_bfloat16;
using bf16x8=__attribute__((ext_vector_type(8)))short;
using s16x4=__attribute__((ext_vector_type(4)))short;
using f32x16=__attribute__((ext_vector_type(16)))float;
using u32x4=__attribute__((ext_vector_type(4)))unsigned;
constexpr int D=64,QP=512,KP=128,OP=1024;
constexpr int NW=8,QBLK=32,QB=QBLK*NW,KVBLK=64;
constexpr int ATTN_UNIT_ROWS=QB;
__device__ __forceinline__ int crow(int r,int hi){return (r&3)+8*(r>>2)+4*hi;}
#define SBAR() __builtin_amdgcn_sched_barrier(0)
constexpr int NSLOT=3, SLOTB=8192;
constexpr int LDS_K=0, LDS_V=NSLOT*SLOTB, LDS_WS=2*NSLOT*SLOTB, LDS_OST=LDS_WS+NW*64*4, LDS_BYTES=LDS_OST+NW*4096;
constexpr float C2=0.125f*1.4426950408889634f;
__device__ __forceinline__ void glds16(const void*gsrc,unsigned lds_dst){unsigned keep;
  asm volatile("s_mov_b32 %0, m0\n\ts_mov_b32 m0, %2\n\ts_nop 0\n\tglobal_load_lds_dwordx4 %1, off\n\ts_mov_b32 m0, %0":"=&s"(keep):"v"(gsrc),"s"(lds_dst):"memory");}
__device__ __forceinline__ float max3f(float a,float b,float c){float r;asm("v_max3_f32 %0, %1, %2, %3":"=v"(r):"v"(a),"v"(b),"v"(c));return r;}
__device__ __forceinline__ float max2f(float a,float b){float r;asm("v_max_f32_e32 %0, %1, %2":"=v"(r):"v"(a),"v"(b));return r;}
__device__ __forceinline__ float fadd_s(float a,float b){float r;asm("v_add_f32_e32 %0, %1, %2":"=v"(r):"v"(a),"v"(b));return r;}
__device__ __forceinline__ float fsub_s(float a,float b){float r;asm("v_sub_f32_e32 %0, %1, %2":"=v"(r):"v"(a),"v"(b));return r;}
typedef float f32x2_t __attribute__((ext_vector_type(2))); typedef __bf16 bf16x2_t __attribute__((ext_vector_type(2)));
__device__ __forceinline__ unsigned cvtpk_s(float lo,float hi){f32x2_t v={lo,hi};bf16x2_t b=__builtin_convertvector(v,bf16x2_t);return __builtin_bit_cast(unsigned,b);}
#define WAIT_BAR(N) asm volatile("s_waitcnt vmcnt(" #N ") lgkmcnt(0)\n\ts_barrier":::"memory")

__device__ __forceinline__ void qkt(f32x16&p0,f32x16&p1,const char*Kslot,const bf16x8*qr,const f32x16&negm,int r32,int hi){
  const char*kb=Kslot+hi*1024+r32*16;
  #pragma unroll
  for(int d0=0;d0<4;++d0){
    const bf16x8 b0=*reinterpret_cast<const bf16x8*>(kb+d0*2048);
    const bf16x8 b1=*reinterpret_cast<const bf16x8*>(kb+d0*2048+512);
    if(d0==0){p0=__builtin_amdgcn_mfma_f32_32x32x16_bf16(b0,qr[0],negm,0,0,0);p1=__builtin_amdgcn_mfma_f32_32x32x16_bf16(b1,qr[0],negm,0,0,0);}
    else{p0=__builtin_amdgcn_mfma_f32_32x32x16_bf16(b0,qr[d0],p0,0,0,0);p1=__builtin_amdgcn_mfma_f32_32x32x16_bf16(b1,qr[d0],p1,0,0,0);}}
}
typedef __attribute__((address_space(3))) const char* lds_cptr;
typedef short v4i16_t __attribute__((ext_vector_type(4)));
__device__ __forceinline__ void kload8(bf16x8*kf,lds_cptr kp){
  kf[0]=*(const __attribute__((address_space(3))) bf16x8*)(kp);      kf[1]=*(const __attribute__((address_space(3))) bf16x8*)(kp+512);
  kf[2]=*(const __attribute__((address_space(3))) bf16x8*)(kp+2048); kf[3]=*(const __attribute__((address_space(3))) bf16x8*)(kp+2560);
  kf[4]=*(const __attribute__((address_space(3))) bf16x8*)(kp+4096); kf[5]=*(const __attribute__((address_space(3))) bf16x8*)(kp+4608);
  kf[6]=*(const __attribute__((address_space(3))) bf16x8*)(kp+6144); kf[7]=*(const __attribute__((address_space(3))) bf16x8*)(kp+6656);
}
__device__ __forceinline__ void kload2(bf16x8*kf,lds_cptr kp,int j){ kf[2*j]=*(const __attribute__((address_space(3))) bf16x8*)(kp+j*2048); kf[2*j+1]=*(const __attribute__((address_space(3))) bf16x8*)(kp+j*2048+512); }
__device__ __forceinline__ s16x4 vtr(lds_cptr p){ return __builtin_bit_cast(s16x4,__builtin_amdgcn_ds_read_tr16_b64_v4i16((__attribute__((address_space(3))) v4i16_t*)p)); }
__device__ __forceinline__ float rowmax(const f32x16&p0,const f32x16&p1){
  float a=max3f(p0[0],p0[1],p1[0]),b=max3f(p0[2],p0[3],p1[1]);a=max3f(a,p1[2],p1[3]);
  #pragma unroll
  for(int r=4;r<16;r+=4){a=max3f(a,p0[r],p0[r+1]);b=max3f(b,p0[r+2],p0[r+3]);a=max3f(a,p1[r],p1[r+1]);b=max3f(b,p1[r+2],p1[r+3]);}
  const float m=max2f(a,b);
  auto rr=__builtin_amdgcn_permlane32_swap(__float_as_uint(m),__float_as_uint(m),false,false);
  return max2f(__uint_as_float(rr[0]),__uint_as_float(rr[1]));
}
__device__ __forceinline__ void pv(f32x16*o,int vb,bf16x8 pa0,bf16x8 pa1,bf16x8 pa2,bf16x8 pa3){
  #pragma unroll
  for(int d0=0;d0<2;++d0){s16x4 lo[4],hi[4];
    #pragma unroll
    for(int ks=0;ks<4;++ks){
      asm volatile("ds_read_b64_tr_b16 %0,%1 offset:%c2":"=&v"(lo[ks]):"v"(vb),"i"(d0*4096+ks*1024):"memory");
      asm volatile("ds_read_b64_tr_b16 %0,%1 offset:%c2":"=&v"(hi[ks]):"v"(vb),"i"(d0*4096+ks*1024+512):"memory");}
    asm volatile("s_waitcnt lgkmcnt(0)":::"memory");SBAR();
    #define PK(k) (bf16x8){lo[k][0],lo[k][1],lo[k][2],lo[k][3],hi[k][0],hi[k][1],hi[k][2],hi[k][3]}
    o[d0]=__builtin_amdgcn_mfma_f32_32x32x16_bf16(pa0,PK(0),o[d0],0,0,0);
    o[d0]=__builtin_amdgcn_mfma_f32_32x32x16_bf16(pa1,PK(1),o[d0],0,0,0);
    o[d0]=__builtin_amdgcn_mfma_f32_32x32x16_bf16(pa2,PK(2),o[d0],0,0,0);
    o[d0]=__builtin_amdgcn_mfma_f32_32x32x16_bf16(pa3,PK(3),o[d0],0,0,0);
    #undef PK
  }
}

#ifndef ATTN_STORE16
#define ATTN_STORE16(p,v) (*(u32x4*)(p)=(v))
#endif
template<int THRL> __device__ __forceinline__ void attn_unit(long qrow0,int h,long krow0,int NT,const bf16*Q,const bf16*__restrict__ K,const bf16*__restrict__ V,bf16*O,char*shm){
  const int tid=ltid(),lane=tid&63,r32=lane&31,hi=lane>>5; const int wid=__builtin_amdgcn_readfirstlane(tid>>6);
  const bf16*Qw=Q+(qrow0+wid*QBLK)*QP+h*D;
  const bf16*Kh=K+krow0*KP+(h>>2)*D,*Vh=V+krow0*KP+(h>>2)*D;
  const unsigned lds0=(unsigned)(uintptr_t)shm;
  float*wsf=(float*)(shm+LDS_WS)+wid*64;
  const bf16*ksrc=Kh+(long)lane*KP+wid*8;
  const bf16*vsrc=Vh+(long)(16*(wid&3)+(lane>>2))*KP+(wid>>2)*32+(lane&3)*8;
  const unsigned kdst=lds0+LDS_K+wid*1024, vdst=lds0+LDS_V+wid*1024;
  #define DMA_K(t,slot) glds16(ksrc+(long)(t)*KVBLK*KP,(unsigned)__builtin_amdgcn_readfirstlane(kdst+(slot)))
  #define DMA_V(t,slot) glds16(vsrc+(long)(t)*KVBLK*KP,(unsigned)__builtin_amdgcn_readfirstlane(vdst+(slot)))
  const int vb0=(int)(lds0+LDS_V)+((lane>>4)&1)*32+(lane&3)*8+(4*hi+((lane&15)>>2))*64;
  const char*Kbase=shm+LDS_K; bf16x8 kf[8];
  const lds_cptr shm3=(lds_cptr)shm; const lds_cptr kp0=shm3+LDS_K+hi*1024+r32*16; const lds_cptr vp0=shm3+LDS_V+((lane>>4)&1)*32+(lane&3)*8+(4*hi+((lane&15)>>2))*64;
  DMA_K(0,0);DMA_V(0,0);DMA_K(1,SLOTB);
  bf16x8 qr[4];
  #pragma unroll
  for(int d0=0;d0<4;++d0)qr[d0]=*reinterpret_cast<const bf16x8*>(&Qw[(long)r32*QP+d0*16+hi*8]);
  float mhat=0.f,l_reg=0.f;f32x16 o[2];o[0]=f32x16{};o[1]=f32x16{};f32x16 negm=f32x16{};asm volatile("":"+v"(negm));
  #define CMASK(P0,P1,t) do{}while(0)
  bool resc=false;
  #define START(P0,P1) do{ const float rm=rowmax(P0,P1); resc=false; \
    { const float dl=rm; mhat=fadd_s(mhat,dl); \
      _Pragma("unroll") for(int r=0;r<16;++r){P0[r]=fsub_s(P0[r],dl);P1[r]=fsub_s(P1[r],dl);} \
      _Pragma("unroll") for(int r=0;r<16;++r)negm[r]=-mhat; asm volatile("":"+v"(negm)); } \
    _Pragma("unroll") for(int r=0;r<16;++r)P0[r]=__builtin_amdgcn_exp2f(P0[r]); }while(0)
  #define RESC() do{ if(resc){ asm volatile("s_waitcnt lgkmcnt(0)":::"memory"); \
      _Pragma("unroll") for(int d_=0;d_<2;++d_) _Pragma("unroll") for(int r=0;r<16;++r)o[d_][r]*=wsf[crow(r,hi)]; } }while(0)
  f32x16 pA0,pA1,pB0,pB1;
  int sl_prev=0,sl_cur=0,sl_next=SLOTB;
  #define ROT() do{sl_prev=sl_cur;sl_cur=sl_next;sl_next=(sl_next==(NSLOT-1)*SLOTB)?0:sl_next+SLOTB;}while(0)
  DMA_K(2,2*SLOTB);
  WAIT_BAR(3);
  qkt(pA0,pA1,Kbase,qr,negm,r32,hi);asm volatile("s_nop 15\n\ts_nop 7":"+v"(pA0),"+v"(pA1));CMASK(pA0,pA1,0);
  START(pA0,pA1);
  _Pragma("unroll") for(int r=0;r<16;++r)pA1[r]=__builtin_amdgcn_exp2f(pA1[r]);
  WAIT_BAR(0);
  DMA_K(3,0);DMA_V(1,SLOTB);
  ROT();
  kload8(kf,kp0+sl_cur);
  WAIT_BAR(2);
  s16x4 vlo[8],vhi[8]; u32x4 pw0,pw1,pw2,pw3;
  #define PKW(P,B) cvtpk_s(P[B],P[B+1])
  #define PAF(k) __builtin_bit_cast(bf16x8,pw##k)
  #define VFR(i) (bf16x8){vlo[i][0],vlo[i][1],vlo[i][2],vlo[i][3],vhi[i][0],vhi[i][1],vhi[i][2],vhi[i][3]}
  #define PIN(x) asm volatile("":"+v"(x))
  #define MX3(a,b,c) __builtin_fmaxf(__builtin_fmaxf((a),(b)),(c))
  #define GAPA(MF,A0,A1,A2,A3,W0,W1,PW) do{ MF; sacc+=A0; sacc+=A1; sacc+=A2; sacc+=A3; PIN(sacc); W0; W1; PIN(PW); SBAR(); }while(0)
  #define EX(v) __builtin_amdgcn_exp2f(v)
  #define GAPB(MF,X,B) do{ MF; X[B]=EX(X[B]); X[B+1]=EX(X[B+1]); X[B+2]=EX(X[B+2]); X[B+3]=EX(X[B+3]); PIN(X); SBAR(); }while(0)
  #define VRD(i) do{ vlo[i]=vtr(vp_+(((i)>>2)*4096+((i)&3)*1024)); vhi[i]=vtr(vp_+(((i)>>2)*4096+((i)&3)*1024+512)); }while(0)
  #define KRD(G,j) do{ if(G){ kload2(kf,kp0+sl_next,j); SBAR(); } }while(0)
  #define STEP(C0,C1,P0,P1,t,GK,GV,GL) do{ SBAR(); \
    const lds_cptr vp_=vp0+sl_prev; \
    VRD(0); SBAR(); float sacc=(P0[0]+P0[1]); \
    GAPA(C0=__builtin_amdgcn_mfma_f32_32x32x16_bf16(kf[0],qr[0],negm,0,0,0), P0[2],P0[3],P0[4],P0[5],     pw0[0]=PKW(P0,0), pw0[1]=PKW(P0,2), pw0); \
    VRD(4); SBAR(); GAPA(C1=__builtin_amdgcn_mfma_f32_32x32x16_bf16(kf[1],qr[0],negm,0,0,0), P0[6],P0[7],P0[8],P0[9],     pw0[2]=PKW(P0,4), pw0[3]=PKW(P0,6), pw0); \
    VRD(1); SBAR(); GAPA(C0=__builtin_amdgcn_mfma_f32_32x32x16_bf16(kf[2],qr[1],C0,0,0,0),   P0[10],P0[11],P0[12],P0[13], pw1[0]=PKW(P0,8), pw1[1]=PKW(P0,10), pw1); \
    VRD(5); SBAR(); GAPA(C1=__builtin_amdgcn_mfma_f32_32x32x16_bf16(kf[3],qr[1],C1,0,0,0),   P0[14],P0[15],P1[0],P1[1],   pw1[2]=PKW(P0,12),pw1[3]=PKW(P0,14), pw1); \
    VRD(2); SBAR(); GAPA(C0=__builtin_amdgcn_mfma_f32_32x32x16_bf16(kf[4],qr[2],C0,0,0,0),   P1[2],P1[3],P1[4],P1[5],     pw2[0]=PKW(P1,0), pw2[1]=PKW(P1,2), pw2); \
    VRD(6); SBAR(); GAPA(C1=__builtin_amdgcn_mfma_f32_32x32x16_bf16(kf[5],qr[2],C1,0,0,0),   P1[6],P1[7],P1[8],P1[9],     pw2[2]=PKW(P1,4), pw2[3]=PKW(P1,6), pw2); \
    VRD(3); SBAR(); GAPA(C0=__builtin_amdgcn_mfma_f32_32x32x16_bf16(kf[6],qr[3],C0,0,0,0),   P1[10],P1[11],P1[12],P1[13], pw3[0]=PKW(P1,8), pw3[1]=PKW(P1,10), pw3); \
    VRD(7); SBAR(); GAPA(C1=__builtin_amdgcn_mfma_f32_32x32x16_bf16(kf[7],qr[3],C1,0,0,0),   P1[14],P1[15],0.f,0.f,       pw3[2]=PKW(P1,12),pw3[3]=PKW(P1,14), pw3); \
    l_reg+=sacc; \
    if(GK){DMA_K((t)+3,sl_cur);} if(GV){DMA_V((t)+1,sl_next);} \
    CMASK(C0,C1,t); \
    { float a=MX3(C0[0],C0[1],C1[0]),b=MX3(C0[2],C0[3],C1[1]); a=MX3(a,C1[2],C1[3]); \
      _Pragma("unroll") for(int r=4;r<16;r+=4){a=MX3(a,C0[r],C0[r+1]);b=MX3(b,C0[r+2],C0[r+3]);a=MX3(a,C1[r],C1[r+1]);b=MX3(b,C1[r+2],C1[r+3]);} \
      float rm=__builtin_fmaxf(a,b); { auto rr=__builtin_amdgcn_permlane32_swap(__float_as_uint(rm),__float_as_uint(rm),false,false); rm=__builtin_fmaxf(__uint_as_float(rr[0]),__uint_as_float(rr[1])); } \
      resc=false; \
      if(__builtin_expect(__any(rm>(float)THRL),0)){ const float dl=__builtin_fmaxf(rm,0.f); mhat+=dl; \
        _Pragma("unroll") for(int r=0;r<16;++r){C0[r]-=dl;C1[r]-=dl;} \
        _Pragma("unroll") for(int r=0;r<16;++r)negm[r]=-mhat; asm volatile("":"+v"(negm)); \
        const float f=__builtin_amdgcn_exp2f(-dl); l_reg*=f; if(hi==0)wsf[r32]=f; resc=true; } } \
    SBAR(); \
    GAPB(o[0]=__builtin_amdgcn_mfma_f32_32x32x16_bf16(PAF(0),VFR(0),o[0],0,0,0), C0,0); \
    GAPB(o[1]=__builtin_amdgcn_mfma_f32_32x32x16_bf16(PAF(0),VFR(4),o[1],0,0,0), C0,4); \
    KRD(GL,0); GAPB(o[0]=__builtin_amdgcn_mfma_f32_32x32x16_bf16(PAF(1),VFR(1),o[0],0,0,0), C0,8); \
    KRD(GL,1); GAPB(o[1]=__builtin_amdgcn_mfma_f32_32x32x16_bf16(PAF(1),VFR(5),o[1],0,0,0), C0,12); \
    KRD(GL,2); GAPB(o[0]=__builtin_amdgcn_mfma_f32_32x32x16_bf16(PAF(2),VFR(2),o[0],0,0,0), C1,0); \
    KRD(GL,3); GAPB(o[1]=__builtin_amdgcn_mfma_f32_32x32x16_bf16(PAF(2),VFR(6),o[1],0,0,0), C1,4); \
    GAPB(o[0]=__builtin_amdgcn_mfma_f32_32x32x16_bf16(PAF(3),VFR(3),o[0],0,0,0), C1,8); \
    GAPB(o[1]=__builtin_amdgcn_mfma_f32_32x32x16_bf16(PAF(3),VFR(7),o[1],0,0,0), C1,12); \
    }while(0)
  int t=1;
  #undef CMASK
  #define CMASK(P0,P1,t) do{}while(0)
  for(;t+5<NT;t+=2){
    STEP(pB0,pB1,pA0,pA1,t,true,true,true);     WAIT_BAR(2); RESC(); ROT();
    STEP(pA0,pA1,pB0,pB1,t+1,true,true,true);   WAIT_BAR(2); RESC(); ROT();
  }
  #undef CMASK
  #define CMASK(P0,P1,t) do{}while(0)
  #define ENDW(tt) do{ if((tt)+3<NT){WAIT_BAR(2);} else if((tt)+2<NT){WAIT_BAR(1);} else {WAIT_BAR(0);} }while(0)
  for(;t+1<NT;t+=2){
    STEP(pB0,pB1,pA0,pA1,t,(t+3<NT),(t+1<NT),(t+1<NT));       ENDW(t);   RESC(); ROT();
    STEP(pA0,pA1,pB0,pB1,t+1,(t+4<NT),(t+2<NT),(t+2<NT));     ENDW(t+1); RESC(); ROT();
  }
  STEP(pB0,pB1,pA0,pA1,NT-1,false,false,false); RESC();
  { float sacc=pB0[0]+pB0[1]; _Pragma("unroll") for(int r=2;r<16;++r)sacc+=pB0[r]; _Pragma("unroll") for(int r=0;r<16;++r)sacc+=pB1[r]; l_reg+=sacc;
    pw0=(u32x4){PKW(pB0,0),PKW(pB0,2),PKW(pB0,4),PKW(pB0,6)};pw1=(u32x4){PKW(pB0,8),PKW(pB0,10),PKW(pB0,12),PKW(pB0,14)};pw2=(u32x4){PKW(pB1,0),PKW(pB1,2),PKW(pB1,4),PKW(pB1,6)};pw3=(u32x4){PKW(pB1,8),PKW(pB1,10),PKW(pB1,12),PKW(pB1,14)};
    SBAR(); pv(o,vb0+sl_cur,PAF(0),PAF(1),PAF(2),PAF(3)); }
  #undef PKW
  #undef PAF
  #undef VFR
  #undef PIN
  #undef MX3
  #undef GAPA
  #undef GAPB
  #undef EX
  #undef VRD
  #undef KRD
  #undef STEP
  #undef ENDW
  {auto rr=__builtin_amdgcn_permlane32_swap(__float_as_uint(l_reg),__float_as_uint(l_reg),false,false);l_reg=__uint_as_float(rr[0])+__uint_as_float(rr[1]);}
  if(hi==0)wsf[32+r32]=l_reg;asm volatile("s_waitcnt lgkmcnt(0)":::"memory");
  float rli[16];
  #pragma unroll
  for(int r=0;r<16;++r)rli[r]=__builtin_amdgcn_rcpf(wsf[32+crow(r,hi)]);
  bf16*Ow=O+(qrow0+wid*QBLK)*OP+h*D;
  { bf16*stg=(bf16*)(shm+LDS_OST)+wid*2048;
    #pragma unroll
    for(int r=0;r<16;++r){const int orow=crow(r,hi);
      #pragma unroll
      for(int d0=0;d0<2;++d0)stg[orow*64+d0*32+r32]=__float2bfloat16(o[d0][r]*rli[r]);}
    asm volatile("s_waitcnt lgkmcnt(0)":::"memory");
    #pragma unroll
    for(int i=0;i<4;++i){const int row=i*8+(lane>>3),ch=lane&7; const u32x4 v=*(const u32x4*)(stg+row*64+ch*8); ATTN_STORE16(Ow+(long)row*OP+ch*8,v);} }
  asm volatile("s_waitcnt lgkmcnt(0)\n\ts_barrier":::"memory");
  #undef DMA_K
  #undef DMA_V
  #undef CMASK
  #undef START
  #undef RESC
  #undef ROT
}
constexpr int ATTN_LDS_BYTES=LDS_BYTES;
#undef SBAR
#undef WAIT_BAR
}

constexpr int NWAVES = 8;
constexpr int NB = 4, TL = 8192, TCX = 256, TP = TL + TCX  , MR = NB * TP  , DM = 1024, NLAYER = 2;
constexpr int RW = 512, NE = 16, FF = 2816;
constexpr int UC = 4864;
constexpr int U_R = 0, U_K = 512, U_V = 1024, U_GLO = 1536, U_DLO = 1696, U_ALO = 1824, RWKV_COLS = 1952, U_Q = 1952, U_KQ = 2464, U_VQ = 2592, U_GR = 2720, U_GA = 3744, IN_COLS = 4768;
constexpr int LK = 768;
constexpr int LOC = 2560;
constexpr int CAP_L = 1024, CAP_C = 32;
constexpr int SLOT_L = NE * NB * CAP_L  , SLOT_ALL = SLOT_L + NE * 256  ;
constexpr float NORM_EPS = 1e-6f, GN_EPS = 64e-5f;
constexpr float QSCALE = 0.125f * 1.4426950408889634f;

constexpr size_t al256(size_t x) { return (x + 255) & ~(size_t)255; }
constexpr size_t WS_CTL = 0, CTL_ZERO_BYTES = 1u << 20;
constexpr size_t WS_MODV = CTL_ZERO_BYTES;
constexpr size_t WS_ROPE = WS_MODV + al256((size_t)2 * 5 * 6144 * 4);
constexpr size_t WS_WIN = WS_ROPE + (size_t)TL * 32 * 8;
constexpr size_t WS_WLORA = WS_WIN + (size_t)2 * UC * DM * 2;
constexpr size_t WS_WBR = WS_WLORA + (size_t)2 * LOC * LK * 2;
constexpr size_t WS_WBA = WS_WBR + (size_t)2 * DM * 512 * 2;
constexpr size_t WS_WOUT = WS_WBA + (size_t)2 * DM * 512 * 2;
constexpr size_t WS_WGU = WS_WOUT + (size_t)2 * DM * DM * 2;
constexpr size_t WS_WD = WS_WGU + (size_t)NE * 2 * FF * DM * 2;
constexpr size_t WS_X = WS_WD + (size_t)NE * DM * FF * 2;
constexpr size_t WS_H = WS_X + (size_t)MR * DM * 4;
constexpr size_t WS_AFF = WS_H + (size_t)MR * DM * 2;
constexpr size_t WS_TOKMAP = WS_AFF + (size_t)MR * 16 * 4;
constexpr size_t WS_IDX = WS_TOKMAP + (size_t)MR * 16 * 4;
constexpr size_t WS_GATEV = WS_IDX + al256((size_t)SLOT_ALL * 4);
constexpr size_t WS_BIG = WS_GATEV + al256((size_t)SLOT_ALL * 4);
constexpr size_t WS_U = WS_BIG;
constexpr size_t WS_RKV = WS_U + (size_t)MR * UC * 2;
constexpr size_t WS_L = WS_RKV + (size_t)MR * 1536 * 2;
constexpr size_t WS_LO = WS_L + (size_t)MR * LK * 2;
constexpr size_t WS_Q = WS_LO + (size_t)MR * LOC * 2;
constexpr size_t WS_KB = WS_Q + (size_t)MR * 512 * 2;
constexpr size_t WS_VB = WS_KB + (size_t)MR * 128 * 2;
constexpr size_t WS_Y = WS_VB + (size_t)MR * 128 * 2;
constexpr size_t WS_YO = WS_Y + (size_t)2 * MR * 512 * 2;
constexpr size_t WS_MIX_END = WS_YO + (size_t)MR * 1024 * 2;
constexpr size_t WS_M1 = WS_RKV;
static_assert(WS_M1 + (size_t)MR * DM * 2 <= WS_Q, "M1 overlay");
constexpr size_t WS_XE = WS_BIG;
constexpr size_t WS_HID = WS_XE + (size_t)SLOT_ALL * DM * 2;
constexpr size_t WS_MOE_END = WS_HID + (size_t)SLOT_ALL * FF * 2;
constexpr size_t WS_END = WS_MIX_END > WS_MOE_END ? WS_MIX_END : WS_MOE_END;
constexpr int CW_TMO = 0, CW_CODE = 1, CW_BAR = 4096;

constexpr int RING_OFF = 0, RING_BYTES = 131072;
constexpr int LDSCTL_OFF = RING_BYTES, MISC_OFF = LDSCTL_OFF + 320;
constexpr int LDS_BYTES = 147456;

#define GAS __attribute__((address_space(1)))
#define LAS __attribute__((address_space(3)))
typedef unsigned short bf16;
typedef unsigned v4u __attribute__((ext_vector_type(4)));
typedef unsigned v2u __attribute__((ext_vector_type(2)));
typedef float f32x4 __attribute__((ext_vector_type(4)));
typedef GAS unsigned gu32;
#define RLX_AGENT __ATOMIC_RELAXED, __HIP_MEMORY_SCOPE_AGENT
#define LDS_WAIT() asm volatile("s_waitcnt lgkmcnt(0)" ::: "memory")
#define VM_WAIT() asm volatile("s_waitcnt vmcnt(0)" ::: "memory")
__device__ __forceinline__ unsigned f2bf(float f) { unsigned u = __builtin_bit_cast(unsigned, f); return (u + 0x7fffu + ((u >> 16) & 1u)) >> 16; }
__device__ __forceinline__ unsigned pk2(float lo, float hi) { return f2bf(lo) | (f2bf(hi) << 16); }
__device__ __forceinline__ float bflo(unsigned u) { return __uint_as_float(u << 16); }
__device__ __forceinline__ float bfhi(unsigned u) { return __uint_as_float(u & 0xffff0000u); }
__device__ __forceinline__ float bf1(bf16 u) { return __uint_as_float((unsigned)u << 16); }
__device__ __forceinline__ float sigm(float x) { return 1.0f / (1.0f + __expf(-x)); }

#define XB_TMO      128
#define XB_XCNT(j)  (256  + 64 * (j))
#define XB_XSUB(j)  (1280 + 64 * (j))
#define XB_XGEN(j)  (2304 + 64 * (j))
#define XB_TOP      3328
#define XB_TOPGEN   3392
#define XCD_BAR_WORDS 3456
#define XB_SPIN_CAP (1u << 18)

__device__ __forceinline__ unsigned xb_ld(unsigned* p)              { return __hip_atomic_load(p, __ATOMIC_RELAXED, __HIP_MEMORY_SCOPE_AGENT); }
__device__ __forceinline__ unsigned xb_add(unsigned* p, unsigned v) { return __hip_atomic_fetch_add(p, v, __ATOMIC_RELAXED, __HIP_MEMORY_SCOPE_AGENT); }
__device__ __forceinline__ unsigned xb_xcc_id() { return (unsigned)__builtin_amdgcn_s_getreg((3 << 11) | 20) & 0xFu; }
#define XB_SPIN(cond, bar) do { unsigned _sp = 0; while (cond) { __builtin_amdgcn_s_sleep(1); \
    if ((++_sp & 255u) == 0u) { if (xb_ld(&(bar)[XB_TMO])) break; if (_sp > XB_SPIN_CAP) { atomicAdd(&(bar)[XB_TMO], 1u); break; } } } } while (0)

struct XcdBarrier {
    unsigned* bar; unsigned x;
    volatile LAS unsigned* st;
};

__device__ __forceinline__ XcdBarrier xcd_barrier_post(unsigned* bar, volatile LAS unsigned* st) {
    XcdBarrier b; b.bar = bar; b.x = xb_xcc_id(); b.st = st;
    if (threadIdx.x == 0) (void)xb_add(&bar[XB_XCNT(b.x)], 1u);
    return b;
}
__device__ __forceinline__ void xcd_barrier_complete(unsigned* bar, unsigned x, unsigned& nloc, unsigned& nx) {
    const unsigned G = gridDim.x * gridDim.y * gridDim.z;
    unsigned sum, cnt, mine, sp = 0u;
    for (;;) {
        sum = 0u; cnt = 0u; mine = 0u;
#pragma unroll
        for (unsigned j = 0; j < 16; ++j) { const unsigned c = xb_ld(&bar[XB_XCNT(j)]); sum += c; cnt += (c > 0u) ? 1u : 0u; mine = (j == x) ? c : mine; }
        if (sum == G) break;
        __builtin_amdgcn_s_sleep(1);
        if ((++sp & 255u) == 0u) { if (xb_ld(&bar[XB_TMO])) break; if (sp > XB_SPIN_CAP) { atomicAdd(&bar[XB_TMO], 1u); break; } }
    }
    nloc = mine > 0u ? mine : 1u; nx = cnt > 0u ? cnt : 1u;
}

__device__ __forceinline__ void xcd_barrier(const XcdBarrier& b) {
    asm volatile("s_waitcnt vmcnt(0)" ::: "memory");
    __syncthreads();
    if (threadIdx.x == 0) {
        unsigned* bar = b.bar;
        __builtin_amdgcn_s_waitcnt(0);
        unsigned nloc = b.st[0], nx = b.st[1];
        if (nloc == 0u) { xcd_barrier_complete(bar, b.x, nloc, nx); b.st[0] = nloc; b.st[1] = nx; }
        const unsigned old = xb_add(&bar[XB_XSUB(b.x)], 1u);
        const unsigned gen = old / nloc;
        if (old + 1u == (gen + 1u) * nloc) {
            __builtin_amdgcn_fence(__ATOMIC_RELEASE, "agent");
            asm volatile("s_waitcnt vmcnt(0)" ::: "memory");
            const unsigned og = xb_add(&bar[XB_TOP], 1u);
            const unsigned tg = og / nx;
            if (og + 1u == (tg + 1u) * nx) xb_add(&bar[XB_TOPGEN], 1u);
            else XB_SPIN(xb_ld(&bar[XB_TOPGEN]) == tg, bar);
            __builtin_amdgcn_fence(__ATOMIC_ACQUIRE, "agent");
            xb_add(&bar[XB_XGEN(b.x)], 1u);
            asm volatile("s_waitcnt vmcnt(0)" ::: "memory");
        } else {
            XB_SPIN(xb_ld(&bar[XB_XGEN(b.x)]) == gen, bar);
            __builtin_amdgcn_fence(__ATOMIC_ACQUIRE, "agent");
            asm volatile("s_waitcnt vmcnt(0)" ::: "memory");
        }
    }
    __syncthreads();
}

struct Args { const float* in[30]; float* out; unsigned char* ws; int ph_lo, ph_hi, use_bar, pad; };
struct Frame {
    LAS unsigned char* lds;
    int tid, lane, wave, vcu, G;
    unsigned char* ws;
};
typedef const __attribute__((address_space(4))) Args* KA;
__device__ __forceinline__ KA kargs() { KA p = (KA)__builtin_amdgcn_kernarg_segment_ptr(); asm volatile("" : "+s"(p)); return p; }
__device__ __forceinline__ Frame mk_frame(KA A) {
    Frame F; F.lds = (LAS unsigned char*)0; F.tid = ltid(); F.lane = F.tid & 63; F.wave = __builtin_amdgcn_readfirstlane(F.tid >> 6);
    F.G = gridDim.x; { const int bx = lbid(); F.vcu = (F.G % 8 == 0) ? (bx % 8) * (F.G / 8) + bx / 8 : bx; }
    F.ws = A->ws; return F;
}
enum { I_X = 0, I_C, I_CTX, I_CCTX, I_WMOD, I_BMOD, I_NMIX, I_NFFN, I_WIN, I_CONVW, I_DW0, I_DW2, I_A0, I_A2, I_G2, I_KEYK, I_KEYA, I_RHO, I_GNG, I_GNB, I_QN, I_KN, I_WBR, I_WBA, I_WOUT, I_WROUTER, I_WGATE, I_WUP, I_WDOWN, I_NFINAL };

__device__ __forceinline__ float wave_sum(float v) {
#pragma unroll
    for (int o = 1; o < 64; o <<= 1) v += __shfl_xor(v, o);
    return v;
}
__device__ __forceinline__ float sum8(float v) { v += __shfl_xor(v, 1); v += __shfl_xor(v, 2); v += __shfl_xor(v, 4); return v; }
#define DPP_ROR_ADD(x, n) (x) += __builtin_bit_cast(float, __builtin_amdgcn_update_dpp(0, __builtin_bit_cast(int, (x)), 0x120 + (n), 0xf, 0xf, false))
__device__ __forceinline__ float red16(float x) { DPP_ROR_ADD(x, 8); DPP_ROR_ADD(x, 4); DPP_ROR_ADD(x, 2); DPP_ROR_ADD(x, 1); return x; }

__device__ __forceinline__ void transpose_item(const float* W, int K, int N, int k0, int n0, bf16* dst, int ldd, LAS float* scr, int lane) {
#pragma unroll 8
    for (int i = 0; i < 32; ++i) { const int kk = 2 * i + (lane >> 5); scr[kk * 33 + (lane & 31)] = W[(size_t)(k0 + kk) * N + n0 + (lane & 31)]; }
    LDS_WAIT(); asm volatile("" ::: "memory");
    const int c = lane & 7;
#pragma unroll
    for (int j = 0; j < 4; ++j) { const int n = (lane >> 3) + 8 * j; const LAS float* s = scr + (8 * c) * 33 + n;
        v4u o; o.x = pk2(s[0 * 33], s[1 * 33]); o.y = pk2(s[2 * 33], s[3 * 33]); o.z = pk2(s[4 * 33], s[5 * 33]); o.w = pk2(s[6 * 33], s[7 * 33]);
        *(GAS v4u*)(dst + (size_t)n * ldd + k0 + 8 * c) = o; }
    LDS_WAIT(); asm volatile("" ::: "memory");
}
__device__ __forceinline__ void transpose_matrix(const Frame& F, const float* W, int K, int N, bf16* WT, int ldd, LAS float* scr, int& itbase) {
    const int gw = F.vcu * NWAVES + F.wave, NGW = F.G * NWAVES;
    const int nblk = N / 32, nit = (K / 64) * nblk;
    int it = ((gw - itbase) % NGW + NGW) % NGW;
    for (; it < nit; it += NGW) { const int kb = it / nblk, nb = it % nblk; transpose_item(W, K, N, 64 * kb, 32 * nb, WT + (size_t)(32 * nb) * ldd, ldd, scr, F.lane); }
    itbase = (itbase + nit) % NGW;
}
__device__ __forceinline__ void cvt_moe(const Frame& F, KA A, int l) {
    LAS float* scr = (LAS float*)(F.lds + RING_OFF + F.wave * 16384);
    const int gw = F.vcu * NWAVES + F.wave, NGW = F.G * NWAVES;
    bf16* Wgu = (bf16*)(F.ws + WS_WGU); bf16* Wd = (bf16*)(F.ws + WS_WD);
    constexpr int IT_G = 16 * 88, IT_D = 44 * 32, PER_E = 2 * IT_G + IT_D;
    for (int it = gw; it < NE * PER_E; it += NGW) {
        const int e = it / PER_E; int r = it % PER_E;
        if (r < 2 * IT_G) { const int up = r >= IT_G; if (up) r -= IT_G; const int kb = r / 88, nb = r % 88, n0 = 32 * nb;
            const float* W = (up ? A->in[I_WUP] : A->in[I_WGATE]) + ((size_t)l * NE + e) * DM * FF;
            transpose_item(W, DM, FF, 64 * kb, n0, Wgu + ((size_t)e * 2 * FF + 256 * (n0 >> 7) + (n0 & 127) + (up ? 128 : 0)) * DM, DM, scr, F.lane);
        } else { r -= 2 * IT_G; const int kb = r / 32, nb = r % 32;
            const float* W = A->in[I_WDOWN] + ((size_t)l * NE + e) * FF * DM;
            transpose_item(W, FF, DM, 64 * kb, 32 * nb, Wd + ((size_t)e * DM + 32 * nb) * FF, FF, scr, F.lane); }
    }
}
__device__ __forceinline__ void p_prologue() {
    KA A = kargs(); const Frame F = mk_frame(A);
    const int gw = F.vcu * NWAVES + F.wave, NGW = F.G * NWAVES;
    const int gt = (F.vcu * NWAVES * 64) + F.tid, NGT = F.G * NWAVES * 64;
    {
        LAS float* SC = (LAS float*)(F.lds);
        LAS float* PS = (LAS float*)(F.lds + 32768);
        if ((int)blockIdx.x < 192) {
            for (int i = F.tid; i < 5 * 1024; i += NWAVES * 64) { const int v = i >> 10, k = i & 1023; const float cv = v < 4 ? A->in[I_C][v * 1024 + k] : A->in[I_CCTX][k]; SC[i] = cv / (1.0f + expf(-cv)); }
            __syncthreads();
            for (int it = blockIdx.x; it < 192; it += F.G) {
                const int l = it / 96, col = (it % 96) * 64 + F.lane;
                const float* W = A->in[I_WMOD] + (size_t)l * DM * 6144 + col;
                float a0 = 0.f, a1 = 0.f, a2 = 0.f, a3 = 0.f, a4 = 0.f;
                const int kb = F.wave * 128;
#pragma unroll 4
                for (int k = 0; k < 128; ++k) { const float w = W[(size_t)(kb + k) * 6144];
                    a0 += SC[kb + k] * w; a1 += SC[1024 + kb + k] * w; a2 += SC[2048 + kb + k] * w; a3 += SC[3072 + kb + k] * w; a4 += SC[4096 + kb + k] * w; }
                PS[(F.wave * 5 + 0) * 64 + F.lane] = a0; PS[(F.wave * 5 + 1) * 64 + F.lane] = a1; PS[(F.wave * 5 + 2) * 64 + F.lane] = a2; PS[(F.wave * 5 + 3) * 64 + F.lane] = a3; PS[(F.wave * 5 + 4) * 64 + F.lane] = a4;
                __syncthreads();
                if (F.tid < 320) { const int v = F.tid >> 6, cl = F.tid & 63; float s = 0.f;
#pragma unroll
                    for (int w = 0; w < 8; ++w) s += PS[(w * 5 + v) * 64 + cl];
                    const int c2 = (it % 96) * 64 + cl;
                    ((float*)(F.ws + WS_MODV))[((size_t)l * 5 + v) * 6144 + c2] = s + A->in[I_BMOD][l * 6144 + c2]; }
                __syncthreads();
            }
        }
        __syncthreads();
    }
    for (int i = gt; i < TL * 32; i += NGT) { const int t = i >> 5, e = i & 31, ax = e >> 4, pr = e & 15;
        const float pos = (float)(ax == 0 ? (t >> 6) : (t & 63)); const float inv = powf(10000.0f, -(float)pr / 16.0f); const float ang = pos * inv;
        ((float2*)(F.ws + WS_ROPE))[i] = make_float2(cosf(ang), sinf(ang)); }
    for (int i = gt; i < 2 * LOC * LK; i += NGT) { const int l = i / (LOC * LK), r = i % (LOC * LK), n = r / LK, k = r % LK; float v = 0.f;
        if (n < 512) { if (k < 160) v = A->in[I_G2][((size_t)l * 160 + k) * 512 + n]; }
        else if (n < 1536) { const int z = (n - 512) >> 9, c = (n - 512) & 511, k0 = 256 + 128 * z; if (k >= k0 && k < k0 + 64) v = A->in[I_DW2][(((size_t)l * 2 + z) * 64 + (k - k0)) * 512 + c]; }
        else { const int z = (n - 1536) >> 9, c = (n - 1536) & 511, k0 = 512 + 128 * z; if (k >= k0 && k < k0 + 64) v = A->in[I_A2][(((size_t)l * 2 + z) * 64 + (k - k0)) * 512 + c]; }
        ((bf16*)(F.ws + WS_WLORA))[i] = (bf16)f2bf(v); }
    for (int i = gt; i < 2 * (UC - IN_COLS) * DM / 8; i += NGT) { const int l = i / ((UC - IN_COLS) * DM / 8), r = i % ((UC - IN_COLS) * DM / 8);
        ((GAS v4u*)(F.ws + WS_WIN + ((size_t)l * UC + IN_COLS) * DM * 2))[r] = (v4u){0u, 0u, 0u, 0u}; }
    LAS float* scr = (LAS float*)(F.lds + RING_OFF + F.wave * 16384);
    int itbase = 0;
#pragma unroll 1
    for (int l = 0; l < NLAYER; ++l) {
        transpose_matrix(F, A->in[I_WIN] + (size_t)l * DM * IN_COLS, DM, IN_COLS, (bf16*)(F.ws + WS_WIN) + (size_t)l * UC * DM, DM, scr, itbase);
        transpose_matrix(F, A->in[I_WBR] + (size_t)l * 512 * DM, 512, DM, (bf16*)(F.ws + WS_WBR) + (size_t)l * DM * DM, DM, scr, itbase);
        transpose_matrix(F, A->in[I_WBA] + (size_t)l * 512 * DM, 512, DM, (bf16*)(F.ws + WS_WBR) + (size_t)l * DM * DM + 512, DM, scr, itbase);
        transpose_matrix(F, A->in[I_WOUT] + (size_t)l * DM * DM, DM, DM, (bf16*)(F.ws + WS_WOUT) + (size_t)l * DM * DM, DM, scr, itbase);
    }
    cvt_moe(F, A, 0);
}

template <int MODE> __device__ __forceinline__ void p_rownorm() {
    KA A = kargs(); const Frame F = mk_frame(A);
    const int gw = F.vcu * NWAVES + F.wave, NGW = F.G * NWAVES;
    constexpr int l = MODE == 0 ? 0 : 1, lprev = MODE == 2 ? 1 : 0;
    float* X = (float*)(F.ws + WS_X); bf16* H = (bf16*)(F.ws + WS_H);
    const float* modv = (const float*)(F.ws + WS_MODV);
    const int* TOKMAP = (const int*)(F.ws + WS_TOKMAP); const bf16* YE = (const bf16*)(F.ws + WS_XE);
    for (int row = gw; row < MR; row += NGW) {
        const int b = row / TP, p = row % TP, sel = p < TCX ? 4 : b;
        if (MODE == 2 && p < TCX) continue;
        const float* src = MODE == 0 ? (p < TCX ? A->in[I_CTX] + ((size_t)b * TCX + p) * DM : A->in[I_X] + ((size_t)b * TL + (p - TCX)) * DM) : X + (size_t)row * DM;
        f32x4 v[4];
#pragma unroll
        for (int j = 0; j < 4; ++j) v[j] = *(const GAS f32x4*)(src + 4 * F.lane + 256 * j);
        if (MODE >= 1) {
            const int tm = TOKMAP[(size_t)row * 16 + (F.lane & 15)];
            f32x4 acc[4];
#pragma unroll
            for (int j = 0; j < 4; ++j) acc[j] = (f32x4){0.f, 0.f, 0.f, 0.f};
#pragma unroll
            for (int e = 0; e < 16; ++e) { const int sr = __builtin_amdgcn_readlane(tm, e);
                if (sr >= 0) { const bf16* yr = YE + (size_t)sr * DM + 4 * F.lane;
#pragma unroll
                    for (int j = 0; j < 4; ++j) { const v2u w = *(const GAS v2u*)(yr + 256 * j); acc[j][0] += bflo(w.x); acc[j][1] += bfhi(w.x); acc[j][2] += bflo(w.y); acc[j][3] += bfhi(w.y); } } }
            const float* g2 = modv + ((size_t)lprev * 5 + sel) * 6144 + 5 * 1024 + 4 * F.lane;
#pragma unroll
            for (int j = 0; j < 4; ++j) v[j] += *(const f32x4*)(g2 + 256 * j) * acc[j];
        }
        float ss = 0.f;
#pragma unroll
        for (int j = 0; j < 4; ++j) ss += (v[j][0] * v[j][0] + v[j][1] * v[j][1]) + (v[j][2] * v[j][2] + v[j][3] * v[j][3]);
        const float rinv = 1.0f / sqrtf(wave_sum(ss) * (1.0f / DM) + NORM_EPS);
        if (MODE == 2) {
            float* o = A->out + ((size_t)b * TL + (p - TCX)) * DM + 4 * F.lane; const float* nf = A->in[I_NFINAL] + 4 * F.lane;
#pragma unroll
            for (int j = 0; j < 4; ++j) *(GAS f32x4*)(o + 256 * j) = v[j] * rinv * *(const f32x4*)(nf + 256 * j);
        } else {
            const float* nw = A->in[I_NMIX] + l * DM + 4 * F.lane; const float* sh = modv + ((size_t)l * 5 + sel) * 6144 + 4 * F.lane; const float* sc = sh + 1024;
            bf16* ho = H + (size_t)row * DM + 4 * F.lane; float* xo = X + (size_t)row * DM + 4 * F.lane;
#pragma unroll
            for (int j = 0; j < 4; ++j) { *(GAS f32x4*)(xo + 256 * j) = v[j];
                const f32x4 hh = v[j] * rinv * *(const f32x4*)(nw + 256 * j) * (1.0f + *(const f32x4*)(sc + 256 * j)) + *(const f32x4*)(sh + 256 * j);
                v2u w; w.x = pk2(hh[0], hh[1]); w.y = pk2(hh[2], hh[3]); *(GAS v2u*)(ho + 256 * j) = w; }
        }
    }
}

__device__ __forceinline__ void ld8(const bf16* p, float (&o)[8]) { const v4u w = *(const GAS v4u*)p; o[0] = bflo(w.x); o[1] = bfhi(w.x); o[2] = bflo(w.y); o[3] = bfhi(w.y); o[4] = bflo(w.z); o[5] = bfhi(w.z); o[6] = bflo(w.w); o[7] = bfhi(w.w); }
__device__ __forceinline__ void up8(const v4u& w, float (&o)[8]) { o[0] = bflo(w.x); o[1] = bfhi(w.x); o[2] = bflo(w.y); o[3] = bfhi(w.y); o[4] = bflo(w.z); o[5] = bfhi(w.z); o[6] = bflo(w.w); o[7] = bfhi(w.w); }
__device__ __forceinline__ void st8(bf16* p, const float (&o)[8]) { v4u w; w.x = pk2(o[0], o[1]); w.y = pk2(o[2], o[3]); w.z = pk2(o[4], o[5]); w.w = pk2(o[6], o[7]); *(GAS v4u*)p = w; }
__device__ __forceinline__ void ldf8(const float* p, float (&o)[8]) { const f32x4 a = *(const f32x4*)p, b = *(const f32x4*)(p + 4); o[0] = a[0]; o[1] = a[1]; o[2] = a[2]; o[3] = a[3]; o[4] = b[0]; o[5] = b[1]; o[6] = b[2]; o[7] = b[3]; }
__device__ __forceinline__ void p_prep_a(int l) {
    KA A = kargs(); const Frame F = mk_frame(A);
    const int gw = F.vcu * NWAVES + F.wave, NGW = F.G * NWAVES, lane = F.lane;
    const bf16* U = (const bf16*)(F.ws + WS_U); bf16* RKV = (bf16*)(F.ws + WS_RKV); bf16* L = (bf16*)(F.ws + WS_L);
    bf16* Q = (bf16*)(F.ws + WS_Q); bf16* KB = (bf16*)(F.ws + WS_KB); bf16* VB = (bf16*)(F.ws + WS_VB);
    const float* cw = A->in[I_CONVW] + (size_t)l * 3 * RWKV_COLS; const float* qn = A->in[I_QN] + l * 64; const float* kn = A->in[I_KN] + l * 64;
    const float2* rope = (const float2*)(F.ws + WS_ROPE);
    constexpr int RB = 16, NRB = MR / RB, NITEM = NRB * 5;
    for (int it = gw; it < NITEM; it += NGW) {
        const int rb = it / 5, pass = it % 5, r0 = rb * RB, p0 = r0 % TP;
        if (pass < 4) {
            const int s = 64 * pass + lane; const bool act = s < 244; const int c0 = act ? 8 * s : 0;
            float w0[8], w1[8], w2[8];
            ldf8(cw + c0, w0); ldf8(cw + RWKV_COLS + c0, w1); ldf8(cw + 2 * RWKV_COLS + c0, w2);
            const bf16* up = U + (size_t)r0 * UC + c0;
            const v4u zero = (v4u){0u, 0u, 0u, 0u};
            v4u a = (p0 != 0 && p0 != TCX) ? *(const GAS v4u*)(up - UC) : zero, b = *(const GAS v4u*)up, c = *(const GAS v4u*)(up + UC), d;
#pragma unroll 4
            for (int t = 0; t < RB; ++t) {
                const int p = p0 + t; const bool hn = (p != TCX - 1 && p != TP - 1);
                const bool hn2 = (p + 1 != TCX - 1 && p + 1 != TP - 1) && hn;
                d = hn2 ? *(const GAS v4u*)(up + (size_t)(t + 2) * UC) : zero;
                float fa[8], fb[8], fc[8], o[8];
                up8(a, fa); up8(b, fb); up8(hn ? c : zero, fc);
#pragma unroll
                for (int e = 0; e < 8; ++e) o[e] = fa[e] * w0[e] + fb[e] * w1[e] + fc[e] * w2[e];
                const size_t row = (size_t)(r0 + t);
                if (pass < 3) st8(RKV + row * 1536 + c0, o);
                else if (act) { const int lo = c0 - 1536;
                    if (lo < 160) {
#pragma unroll
                        for (int e = 0; e < 8; ++e) o[e] = __builtin_amdgcn_rcpf(1.0f + __expf(-o[e])); }
                    else if (lo < 288) {
#pragma unroll
                        for (int e = 0; e < 8; ++e) o[e] = 1.0f - 2.0f * __builtin_amdgcn_rcpf(1.0f + __expf(2.0f * o[e])); }
                    const int lc = lo < 160 ? lo : (lo < 224 ? 256 + (lo - 160) : (lo < 288 ? 384 + (lo - 224) : (lo < 352 ? 512 + (lo - 288) : 640 + (lo - 352))));
                    st8(L + row * LK + lc, o); }
                if (pass == 3 && lane < 44) {
                    const int pc = lane < 12 ? 160 + 8 * lane : (lane < 20 ? 320 + 8 * (lane - 12) : (lane < 28 ? 448 + 8 * (lane - 20) : (lane < 36 ? 576 + 8 * (lane - 28) : 704 + 8 * (lane - 36))));
                    *(GAS v4u*)(L + row * LK + pc) = zero; }
                a = hn ? b : zero; b = c; c = d;
            }
        } else {
            const int m = lane & 7, ax = m >> 2, hf = (m >> 1) & 1, sl = lane & 15;
            float gq[8], gk[8]; ldf8(qn + 8 * m, gq); ldf8(kn + 8 * m, gk);
#pragma unroll 2
            for (int t = 0; t < RB; ++t) {
                const int p = p0 + t; const bool isctx = p < TCX; const size_t row = (size_t)(r0 + t);
                const bf16* u0 = U + row * UC;
                const v4u qw = *(const GAS v4u*)(u0 + U_Q + 8 * lane), kw = *(const GAS v4u*)(u0 + U_KQ + 8 * sl), vw = *(const GAS v4u*)(u0 + U_VQ + 8 * sl);
                float cs[8], sn[8];
                if (!isctx) { const float2* rp = rope + (size_t)(p - TCX) * 32 + ax * 16 + 8 * (m & 1);
#pragma unroll
                    for (int e = 0; e < 8; e += 2) { const f32x4 tt = *(const f32x4*)(rp + e); cs[e] = tt[0]; sn[e] = tt[1]; cs[e + 1] = tt[2]; sn[e + 1] = tt[3]; } }
                else {
#pragma unroll
                    for (int e = 0; e < 8; ++e) { cs[e] = 1.f; sn[e] = 0.f; } }
                float q[8], k[8]; up8(qw, q); up8(kw, k);
                float sq = 0.f, sk = 0.f;
#pragma unroll
                for (int e = 0; e < 8; ++e) { sq += q[e] * q[e]; sk += k[e] * k[e]; }
                const float rq = __builtin_amdgcn_rsqf(sum8(sq) * (1.0f / 64.0f) + NORM_EPS), rk = __builtin_amdgcn_rsqf(sum8(sk) * (1.0f / 64.0f) + NORM_EPS);
                float oq[8], ok[8];
#pragma unroll
                for (int e = 0; e < 8; ++e) { q[e] = q[e] * rq * gq[e]; k[e] = k[e] * rk * gk[e]; }
#pragma unroll
                for (int e = 0; e < 8; ++e) { const float pq = __shfl_xor(q[e], 2), pk = __shfl_xor(k[e], 2);
                    oq[e] = (hf == 0 ? q[e] * cs[e] - pq * sn[e] : q[e] * cs[e] + pq * sn[e]) * QSCALE;
                    ok[e] = (hf == 0 ? k[e] * cs[e] - pk * sn[e] : k[e] * cs[e] + pk * sn[e]); }
                st8(Q + row * 512 + 8 * lane, oq);
                if (lane < 16) st8(KB + row * 128 + 8 * sl, ok);
                else if (lane < 32) *(GAS v4u*)(VB + row * 128 + 8 * sl) = vw;
            }
        }
    }
}

__device__ __forceinline__ void p_post(int l) {
    KA A = kargs(); const Frame F = mk_frame(A);
    const int gw = F.vcu * NWAVES + F.wave, NGW = F.G * NWAVES, lane = F.lane, c0 = 8 * lane;
    const bf16* Y = (const bf16*)(F.ws + WS_Y); const bf16* RKV = (const bf16*)(F.ws + WS_RKV); const bf16* LO = (const bf16*)(F.ws + WS_LO); bf16* YR = (bf16*)(F.ws + WS_YO);
    float gg[8], gb[8], ka[8], rho[8];
    ldf8(A->in[I_GNG] + l * 512 + c0, gg); ldf8(A->in[I_GNB] + l * 512 + c0, gb); ldf8(A->in[I_KEYA] + l * 512 + c0, ka); ldf8(A->in[I_RHO] + l * 512 + c0, rho);
    for (int row = gw; row < MR; row += NGW) {
        if (l == NLAYER - 1 && (row % TP) < TCX) continue;
        float y[8], y1[8]; ld8(Y + (size_t)row * 512 + c0, y); ld8(Y + ((size_t)MR + row) * 512 + c0, y1);
        float s = 0.f;
#pragma unroll
        for (int e = 0; e < 8; ++e) { y[e] += y1[e]; s += y[e]; }
        const float mu = sum8(s) * (1.0f / 64.0f); float q = 0.f;
#pragma unroll
        for (int e = 0; e < 8; ++e) { y[e] -= mu; q += y[e] * y[e]; }
        const float rstd = 1.0f / sqrtf(sum8(q) * (1.0f / 64.0f) + GN_EPS);
        float r[8], k[8], v[8], a0[8], a1[8], g[8];
        ld8(RKV + (size_t)row * 1536 + c0, r); ld8(RKV + (size_t)row * 1536 + 512 + c0, k); ld8(RKV + (size_t)row * 1536 + 1024 + c0, v);
        ld8(LO + (size_t)row * LOC + 1536 + c0, a0); ld8(LO + (size_t)row * LOC + 2048 + c0, a1); ld8(LO + (size_t)row * LOC + c0, g);
        float bs = 0.f;
#pragma unroll
        for (int e = 0; e < 8; ++e) { const float kr = k[e] * (1.0f + (a0[e] - 1.0f) * ka[e]) + k[e] * (1.0f + (a1[e] - 1.0f) * ka[e]); bs += r[e] * kr * rho[e]; }
        const float bon = sum8(bs);
        float o[8];
#pragma unroll
        for (int e = 0; e < 8; ++e) o[e] = ((y[e] * rstd * gg[e] + gb[e]) + bon * v[e]) * g[e];
        st8(YR + (size_t)row * 1024 + c0, o);
    }
}

#define DPPF(x, ctrl) __builtin_bit_cast(float, __builtin_amdgcn_update_dpp(0, __builtin_bit_cast(int, (x)), (ctrl), 0xf, 0xf, false))
__device__ __forceinline__ float reduce16_to_lane(const float (&p)[16], int lane) {
    const bool b3 = lane & 8, b2 = lane & 4, b1 = lane & 2, b0 = lane & 1;
    float q8[8], q4[4], q2[2];
#pragma unroll
    for (int e = 0; e < 8; ++e) { const float keep = b3 ? p[e + 8] : p[e], send = b3 ? p[e] : p[e + 8]; q8[e] = keep + DPPF(send, 0x140); }
#pragma unroll
    for (int e = 0; e < 4; ++e) { const float keep = b2 ? q8[e + 4] : q8[e], send = b2 ? q8[e] : q8[e + 4]; q4[e] = keep + DPPF(send, 0x141); }
#pragma unroll
    for (int e = 0; e < 2; ++e) { const float keep = b1 ? q4[e + 2] : q4[e], send = b1 ? q4[e] : q4[e + 2]; q2[e] = keep + DPPF(send, 0x4E); }
    const float keep = b0 ? q2[1] : q2[0], send = b0 ? q2[0] : q2[1];
    float x = keep + DPPF(send, 0xB1);
    x += __shfl_xor(x, 16); x += __shfl_xor(x, 32);
    return x;
}
__device__ __forceinline__ float rowmax16(float x) { x = fmaxf(x, DPPF(x, 0x128)); x = fmaxf(x, DPPF(x, 0x124)); x = fmaxf(x, DPPF(x, 0x122)); x = fmaxf(x, DPPF(x, 0x121)); return x; }
__device__ __forceinline__ void p_norm2(int l) {
    KA A = kargs(); const Frame F = mk_frame(A);
    const int gw = F.vcu * NWAVES + F.wave, NGW = F.G * NWAVES, lane = F.lane;
    LAS float* WRt = (LAS float*)(F.lds);
    for (int i = F.tid; i < 16 * 1024; i += NWAVES * 64) { const int e = i >> 10, c = i & 1023; WRt[i] = A->in[I_WROUTER][(size_t)l * DM * 16 + c * 16 + e]; }
    __syncthreads();
    const float* X = (const float*)(F.ws + WS_X); bf16* H = (bf16*)(F.ws + WS_H); float* AFF = (float*)(F.ws + WS_AFF);
    const float* modv = (const float*)(F.ws + WS_MODV);
    const bool lat_only = (l == NLAYER - 1); const int nrows = lat_only ? NB * TL : MR;
#define N2_ROW(q) (lat_only ? ((q) / TL) * TP + TCX + ((q) % TL) : (q))
    f32x4 nx[4];
    if (gw < nrows) { const int row = N2_ROW(gw);
#pragma unroll
        for (int j = 0; j < 4; ++j) nx[j] = *(const GAS f32x4*)(X + (size_t)row * DM + 4 * lane + 256 * j); }
    for (int q = gw; q < nrows; q += NGW) {
        const int row = N2_ROW(q), b = row / TP, p = row % TP, sel = p < TCX ? 4 : b;
        f32x4 v[4];
#pragma unroll
        for (int j = 0; j < 4; ++j) v[j] = nx[j];
        if (q + NGW < nrows) { const int rown = N2_ROW(q + NGW);
#pragma unroll
            for (int j = 0; j < 4; ++j) nx[j] = *(const GAS f32x4*)(X + (size_t)rown * DM + 4 * lane + 256 * j); }
        float ss = 0.f;
#pragma unroll
        for (int j = 0; j < 4; ++j) ss += (v[j][0] * v[j][0] + v[j][1] * v[j][1]) + (v[j][2] * v[j][2] + v[j][3] * v[j][3]);
        const float rinv = 1.0f / sqrtf(wave_sum(ss) * (1.0f / DM) + NORM_EPS);
        const float* nw = A->in[I_NFFN] + l * DM + 4 * lane; const float* sh = modv + ((size_t)l * 5 + sel) * 6144 + 3 * 1024 + 4 * lane; const float* sc = sh + 1024;
        bf16* ho = H + (size_t)row * DM + 4 * lane;
#pragma unroll
        for (int j = 0; j < 4; ++j) { v[j] = v[j] * rinv * *(const f32x4*)(nw + 256 * j) * (1.0f + *(const f32x4*)(sc + 256 * j)) + *(const f32x4*)(sh + 256 * j);
            v2u w; w.x = pk2(v[j][0], v[j][1]); w.y = pk2(v[j][2], v[j][3]); *(GAS v2u*)(ho + 256 * j) = w; }
        float lg[16];
        const unsigned wad = 16u * (unsigned)lane;
#pragma unroll
        for (int g = 0; g < 4; ++g) {
            f32x4 w[4][4];
            asm volatile("ds_read_b128 %0, %16 offset:%17\n\tds_read_b128 %1, %16 offset:%17+1024\n\tds_read_b128 %2, %16 offset:%17+2048\n\tds_read_b128 %3, %16 offset:%17+3072\n\t"
                         "ds_read_b128 %4, %16 offset:%17+4096\n\tds_read_b128 %5, %16 offset:%17+5120\n\tds_read_b128 %6, %16 offset:%17+6144\n\tds_read_b128 %7, %16 offset:%17+7168\n\t"
                         "ds_read_b128 %8, %16 offset:%17+8192\n\tds_read_b128 %9, %16 offset:%17+9216\n\tds_read_b128 %10, %16 offset:%17+10240\n\tds_read_b128 %11, %16 offset:%17+11264\n\t"
                         "ds_read_b128 %12, %16 offset:%17+12288\n\tds_read_b128 %13, %16 offset:%17+13312\n\tds_read_b128 %14, %16 offset:%17+14336\n\tds_read_b128 %15, %16 offset:%17+15360\n\t"
                         "s_waitcnt lgkmcnt(0)"
                : "=&v"(w[0][0]), "=&v"(w[0][1]), "=&v"(w[0][2]), "=&v"(w[0][3]), "=&v"(w[1][0]), "=&v"(w[1][1]), "=&v"(w[1][2]), "=&v"(w[1][3]),
                  "=&v"(w[2][0]), "=&v"(w[2][1]), "=&v"(w[2][2]), "=&v"(w[2][3]), "=&v"(w[3][0]), "=&v"(w[3][1]), "=&v"(w[3][2]), "=&v"(w[3][3])
                : "v"(wad), "i"(g * 16384) : "memory");
#pragma unroll
            for (int ee = 0; ee < 4; ++ee) { float s = 0.f;
#pragma unroll
                for (int j = 0; j < 4; ++j) s += (v[j][0] * w[ee][j][0] + v[j][1] * w[ee][j][1]) + (v[j][2] * w[ee][j][2] + v[j][3] * w[ee][j][3]);
                lg[4 * g + ee] = s; }
        }
        const float mylg = reduce16_to_lane(lg, lane);
        const float mx = rowmax16(mylg);
        const float ex = expf(mylg - mx);
        const float den = red16(ex);
        if (lane < 16) AFF[(size_t)row * 16 + lane] = ex / den;
    }
#undef N2_ROW
    __syncthreads();
}

__device__ __forceinline__ int block_excl_scan(int v, LAS int* tmp, int tid, int lane, int wave, int& total) {
    int inc = v;
#pragma unroll
    for (int o = 1; o < 64; o <<= 1) { const int t = __shfl_up(inc, o); if (lane >= o) inc += t; }
    __syncthreads();
    if (lane == 63) tmp[wave] = inc;
    __syncthreads();
    int base = 0, tot = 0;
#pragma unroll
    for (int w = 0; w < NWAVES; ++w) { const int t = tmp[w]; if (w < wave) base += t; tot += t; }
    total = tot;
    return base + inc - v;
}
__device__ __forceinline__ void p_topk(int l) {
    KA A = kargs(); const Frame F = mk_frame(A);
    LAS int* hist = (LAS int*)(F.lds);
    LAS int* hist2 = hist + 256;
    LAS int* sel = hist + 512;
    LAS int* tmp = hist + 528;
    const float* AFF = (const float*)(F.ws + WS_AFF); int* TOKMAP = (int*)(F.ws + WS_TOKMAP); int* IDX = (int*)(F.ws + WS_IDX); float* GATEV = (float*)(F.ws + WS_GATEV);
    const int nprob = (l == 0) ? 128 : 64, tid = F.tid;
    for (int pid = blockIdx.x; pid < nprob; pid += F.G) {
        const bool isc = pid >= 64; const int q = pid & 63, b = q >> 4, e = q & 15;
        const int n = isc ? TCX : TL, C = isc ? CAP_C : CAP_L, rowbase = b * TP + (isc ? 0 : TCX);
        const int slotbase = isc ? (SLOT_L + e * 256 + b * CAP_C) : (e * (NB * CAP_L) + b * CAP_L);
        const int t0 = 16 * tid; const bool valid = t0 < n;
        unsigned key[16];
#pragma unroll
        for (int k = 0; k < 16; ++k) key[k] = valid ? __float_as_uint(AFF[(size_t)(rowbase + t0 + k) * 16 + e]) : 0u;
        unsigned prefix = 0u, mask = 0u; int remaining = C;
#pragma unroll 1
        for (int pass = 0; pass < 4; ++pass) { const int shift = 24 - 8 * pass;
            if (tid < 256) hist[tid] = 0;
            __syncthreads();
            if (valid) {
#pragma unroll
                for (int k = 0; k < 16; ++k) if ((key[k] & mask) == prefix) atomicAdd((int*)&hist[(key[k] >> shift) & 255u], 1); }
            __syncthreads();
            LAS int* src = hist; LAS int* dst = hist2;
#pragma unroll 1
            for (int off = 1; off < 256; off <<= 1) { if (tid < 256) dst[tid] = src[tid] + (tid + off < 256 ? src[tid + off] : 0); __syncthreads(); LAS int* t = src; src = dst; dst = t; }
            if (tid < 256) { const int sd = src[tid], sn = tid < 255 ? src[tid + 1] : 0; if (sd >= remaining && sn < remaining) { sel[0] = tid; sel[1] = remaining - sn; } }
            __syncthreads();
            prefix |= (unsigned)sel[0] << shift; mask |= 255u << shift; remaining = sel[1];
            __syncthreads();
        }
        int ceq = 0;
#pragma unroll
        for (int k = 0; k < 16; ++k) ceq += (valid && key[k] == prefix) ? 1 : 0;
        int tot; int eqrank = block_excl_scan(ceq, tmp, tid, F.lane, F.wave, tot);
        unsigned selmask = 0u; int csel = 0;
#pragma unroll
        for (int k = 0; k < 16; ++k) { bool s = false; if (valid) { if (key[k] > prefix) s = true; else if (key[k] == prefix) { s = eqrank < remaining; ++eqrank; } } if (s) { selmask |= 1u << k; ++csel; } }
        int pos = block_excl_scan(csel, tmp, tid, F.lane, F.wave, tot);
        if (valid) {
#pragma unroll
            for (int k = 0; k < 16; ++k) { const int row = rowbase + t0 + k;
                if (selmask & (1u << k)) { const int sr = slotbase + pos; ++pos; IDX[sr] = row; GATEV[sr] = __uint_as_float(key[k]); TOKMAP[(size_t)row * 16 + e] = sr; }
                else TOKMAP[(size_t)row * 16 + e] = -1; } }
        if (isc && b == 0 && tid >= 128 && tid < 256) { IDX[SLOT_L + e * 256 + tid] = -1; GATEV[SLOT_L + e * 256 + tid] = 0.f; }
        __syncthreads();
    }
}

__device__ __forceinline__ void p_gather(int l) {
    KA A = kargs(); const Frame F = mk_frame(A);
    const int gw = F.vcu * NWAVES + F.wave, NGW = F.G * NWAVES, lane = F.lane;
    const bf16* H = (const bf16*)(F.ws + WS_H); bf16* XE = (bf16*)(F.ws + WS_XE); const int* IDX = (const int*)(F.ws + WS_IDX);
    const int ns = (l == 0) ? SLOT_ALL : SLOT_L;
    for (int sr = gw; sr < ns; sr += NGW) { const int idx = IDX[sr];
        v4u a = (v4u){0u, 0u, 0u, 0u}, b2 = a;
        if (idx >= 0) { a = *(const GAS v4u*)(H + (size_t)idx * DM + 8 * lane); b2 = *(const GAS v4u*)(H + (size_t)idx * DM + 512 + 8 * lane); }
        *(GAS v4u*)(XE + (size_t)sr * DM + 8 * lane) = a; *(GAS v4u*)(XE + (size_t)sr * DM + 512 + 8 * lane) = b2; }
}
constexpr int SC_CH = 32, SC_STR = 340, SC_NC = TP / SC_CH;
__device__ __forceinline__ int scan_p(int s, int z) { return z == 0 ? s : (s < TCX ? (TCX - 1 - s) : (TP + TCX - 1 - s)); }
#define SC_BAR() asm volatile("s_waitcnt lgkmcnt(0)\n\ts_barrier" ::: "memory")
struct ScanRaw { v4u r, k, a, w, v; };
__device__ __forceinline__ void scan_ldraw(ScanRaw& R, int c, int lw, int lane, int b, int h, int z, int rg, const bf16* RKV, const bf16* LO) {
    const int sg = lane >> 3, ko = lane & 7, s = c * SC_CH + 8 * lw + sg; const size_t row = (size_t)b * TP + scan_p(s, z);
    const bf16* rp = RKV + row * 1536 + h * 64 + 8 * ko; const bf16* lp = LO + row * LOC + 512 * z + h * 64 + 8 * ko;
    R.r = *(const GAS v4u*)rp; R.k = *(const GAS v4u*)(rp + 512); R.a = *(const GAS v4u*)(lp + 1536); R.w = *(const GAS v4u*)(lp + 512);
    R.v = *(const GAS v4u*)(RKV + row * 1536 + 1024 + h * 64 + 16 * rg + 8 * (ko & 1));
}
__device__ __forceinline__ float h2f(unsigned short u) { return (float)__builtin_bit_cast(_Float16, u); }
__device__ __forceinline__ void scan_put(const ScanRaw& R, int c, int lw, int lane, LAS float* lds0, const float (&keyk)[8], const float (&keya)[8]) {
    const int sg = lane >> 3, ko = lane & 7;
    LAS float* base = lds0 + (c & 1) * (SC_CH * SC_STR) + (8 * lw + sg) * SC_STR + 8 * ko;
    float r[8], k[8], a[8], w[8], kk[8];
    up8(R.r, r); up8(R.k, k); up8(R.a, a);
    w[0] = h2f((unsigned short)R.w.x); w[1] = h2f((unsigned short)(R.w.x >> 16)); w[2] = h2f((unsigned short)R.w.y); w[3] = h2f((unsigned short)(R.w.y >> 16));
    w[4] = h2f((unsigned short)R.w.z); w[5] = h2f((unsigned short)(R.w.z >> 16)); w[6] = h2f((unsigned short)R.w.w); w[7] = h2f((unsigned short)(R.w.w >> 16));
    float ss = 0.f;
#pragma unroll
    for (int e = 0; e < 8; ++e) { kk[e] = k[e] * keyk[e]; ss += kk[e] * kk[e]; }
    const float rn = __builtin_amdgcn_rsqf(sum8(ss) + 1e-12f);
    f32x4 o0, o1;
#define PUT2(off, expr) do { _Pragma("unroll") for (int e = 0; e < 4; ++e) { { const int E = e; o0[e] = (expr); } { const int E = e + 4; o1[e] = (expr); } } \
        *(LAS f32x4*)(base + (off)) = o0; *(LAS f32x4*)(base + (off) + 4) = o1; } while (0)
    float c1 = 0.f, c2 = 0.f;
#pragma unroll
    for (int e = 0; e < 8; ++e) { const float nka = -(kk[e] * rn * a[e]), kr = k[e] * (1.0f + (a[e] - 1.0f) * keya[e]); c1 += kr * r[e]; c2 += nka * r[e]; }
    c1 = sum8(c1); c2 = sum8(c2);
    PUT2(0, kk[E] * rn); PUT2(64, w[E]); PUT2(128, -(kk[E] * rn * a[E])); PUT2(192, k[E] * (1.0f + (a[E] - 1.0f) * keya[E])); PUT2(256, w[E] * r[E]);
#undef PUT2
    if (ko == 2) { base[-16 + 336] = c1; base[-16 + 337] = c2; }
    if (ko < 2) { float v[8]; up8(R.v, v); *(LAS f32x4*)(base - 8 * ko + 320 + 8 * ko) = (f32x4){v[0], v[1], v[2], v[3]}; *(LAS f32x4*)(base - 8 * ko + 320 + 8 * ko + 4) = (f32x4){v[4], v[5], v[6], v[7]}; }
}
typedef float f32x2s __attribute__((ext_vector_type(2)));
struct ScanOps { f32x4 kk, w, ka, kr, r; float v; f32x2s c; };
#define SC_ISSUE(O, A128, A32, AC, OFF) asm volatile("ds_read_b128 %0, %7 offset:%10\n\tds_read_b128 %1, %7 offset:%11\n\tds_read_b128 %2, %7 offset:%12\n\tds_read_b128 %3, %7 offset:%13\n\tds_read_b128 %4, %7 offset:%14\n\tds_read_b32 %5, %8 offset:%10\n\tds_read_b64 %6, %9 offset:%10" \
    : "=&v"(O.kk), "=&v"(O.w), "=&v"(O.ka), "=&v"(O.kr), "=&v"(O.r), "=&v"(O.v), "=&v"(O.c) : "v"(A128), "v"(A32), "v"(AC), "i"(OFF), "i"((OFF) + 256), "i"((OFF) + 512), "i"((OFF) + 768), "i"((OFF) + 1024) : "memory")
#define SC_LANDED(O) asm volatile("s_waitcnt lgkmcnt(0)" : "+v"(O.kk), "+v"(O.w), "+v"(O.ka), "+v"(O.kr), "+v"(O.r), "+v"(O.v), "+v"(O.c) :: "memory")
__device__ __forceinline__ float scan_step(f32x4& S, const ScanOps& C) {
    float d = S[0] * C.kk[0]; d = fmaf(S[1], C.kk[1], d); d = fmaf(S[2], C.kk[2], d); d = fmaf(S[3], C.kk[3], d);
    float q = S[0] * C.r[0]; q = fmaf(S[1], C.r[1], q); q = fmaf(S[2], C.r[2], q); q = fmaf(S[3], C.r[3], q);
    DPP_ROR_ADD(d, 8); DPP_ROR_ADD(q, 8); DPP_ROR_ADD(d, 4); DPP_ROR_ADD(q, 4); DPP_ROR_ADD(d, 2); DPP_ROR_ADD(q, 2); DPP_ROR_ADD(d, 1); DPP_ROR_ADD(q, 1);
    f32x4 T;
#pragma unroll
    for (int e = 0; e < 4; ++e) T[e] = fmaf(C.v, C.kr[e], S[e] * C.w[e]);
#pragma unroll
    for (int e = 0; e < 4; ++e) S[e] = fmaf(d, C.ka[e], T[e]);
    return fmaf(d, C.c[1], fmaf(C.v, C.c[0], q));
}
template <int XMODE> __device__ __forceinline__ void p_scan(int l) {
    KA A = kargs(); const Frame F = mk_frame(A);
    const bf16* RKV = (const bf16*)(F.ws + WS_RKV); const bf16* LO = (const bf16*)(F.ws + WS_LO); bf16* Y = (bf16*)(F.ws + WS_Y);
    const int lane = F.lane;
    LAS float* lds0 = (LAS float*)(F.lds);
    for (int task = lbid(); task < 256; task += F.G) {
        const int chain = task >> 2, rg = task & 3, b = chain >> 4, h = (chain >> 1) & 7, z = chain & 1;
        if (F.wave >= 4) {
            const int lw = F.wave - 4;
            float keyk[8], keya[8]; ldf8(A->in[I_KEYK] + l * 512 + h * 64 + 8 * (lane & 7), keyk); ldf8(A->in[I_KEYA] + l * 512 + h * 64 + 8 * (lane & 7), keya);
            ScanRaw RA, RB;
            if (XMODE == 1) { for (int c = 0; c < SC_NC + 1; ++c) SC_BAR(); continue; }
            scan_ldraw(RA, 0, lw, lane, b, h, z, rg, RKV, LO); scan_ldraw(RB, 1, lw, lane, b, h, z, rg, RKV, LO);
            scan_put(RA, 0, lw, lane, lds0, keyk, keya);
            scan_ldraw(RA, 2, lw, lane, b, h, z, rg, RKV, LO);
            SC_BAR();
#pragma unroll 1
            for (int c = 0; c < SC_NC; c += 2) {
                scan_put(RB, c + 1, lw, lane, lds0, keyk, keya);
                if (c + 3 < SC_NC) scan_ldraw(RB, c + 3, lw, lane, b, h, z, rg, RKV, LO);
                SC_BAR();
                if (c + 2 < SC_NC) scan_put(RA, c + 2, lw, lane, lds0, keyk, keya);
                if (c + 4 < SC_NC) scan_ldraw(RA, c + 4, lw, lane, b, h, z, rg, RKV, LO);
                SC_BAR();
            }
        } else {
            const int r = lane >> 4, j = lane & 15, cw = F.wave, vi = 4 * cw + r;
            if (XMODE == 2) { for (int c = 0; c < SC_NC + 1; ++c) SC_BAR(); continue; }
            __builtin_amdgcn_s_setprio(3);
            f32x4 S = (f32x4){0.f, 0.f, 0.f, 0.f};
            bf16* yout = Y + ((size_t)z * MR + (size_t)b * TP) * 512 + h * 64 + 16 * rg + 4 * cw + r;
            SC_BAR();
#pragma unroll 1
            for (int c = 0; c < SC_NC; ++c) {
                const unsigned bufb = (unsigned)((c & 1) * (SC_CH * SC_STR * 4));
                asm volatile(".p2align 3");
                const unsigned a128 = bufb + 16u * (unsigned)j, a32 = bufb + 4u * (unsigned)(320 + vi), ac = bufb + 4u * 336u;
                ScanOps P, Qn; float yk0 = 0.f, yk1 = 0.f;
                SC_ISSUE(P, a128, a32, ac, 0); SC_LANDED(P);
#pragma unroll
                for (int ii = 0; ii < SC_CH; ii += 2) {
                    SC_ISSUE(Qn, a128, a32, ac, (ii + 1) * SC_STR * 4); __builtin_amdgcn_sched_barrier(0);
                    { const float y = scan_step(S, P); if (ii < 16) yk0 = (j == ii) ? y : yk0; else yk1 = (j == ii - 16) ? y : yk1; }
                    asm volatile("" : "+v"(S)); __builtin_amdgcn_sched_barrier(0); SC_LANDED(Qn);
                    if (ii + 2 < SC_CH) SC_ISSUE(P, a128, a32, ac, (ii + 2) * SC_STR * 4);
                    __builtin_amdgcn_sched_barrier(0);
                    { const float y = scan_step(S, Qn); if (ii + 1 < 16) yk0 = (j == ii + 1) ? y : yk0; else yk1 = (j == ii + 1 - 16) ? y : yk1; }
                    asm volatile("" : "+v"(S)); __builtin_amdgcn_sched_barrier(0);
                    if (ii + 2 < SC_CH) SC_LANDED(P);
                }
                yout[(size_t)scan_p(c * SC_CH + j, z) * 512] = (bf16)f2bf(yk0);
                yout[(size_t)scan_p(c * SC_CH + 16 + j, z) * 512] = (bf16)f2bf(yk1);
                SC_BAR();
            }
            __builtin_amdgcn_s_setprio(0);
        }
    }
    __syncthreads();
}

__device__ __forceinline__ void p_attn(char* lds, int l) {
    KA A = kargs(); const Frame F = mk_frame(A);
    const attn_body::bf16* Q = (const attn_body::bf16*)(F.ws + WS_Q); const attn_body::bf16* K = (const attn_body::bf16*)(F.ws + WS_KB); const attn_body::bf16* V = (const attn_body::bf16*)(F.ws + WS_VB);
    const int NU = 1024 + (l == 0 ? 32 : 0);
    for (int u = F.vcu; u < NU; u += F.G) {
        if (u < 1024) { const int i = u >> 8, v = u & 255, bh = v >> 3, s = v & 7, b = bh >> 3, h = bh & 7;
            const int qb = (i == 0) ? s : (i == 1) ? 15 - s : (i == 2) ? 16 + s : 31 - s;
            attn_body::attn_unit<8>((long)b * TP + TCX + 256 * qb, h, (long)b * TP, TP / 64, Q, K, V, (attn_body::bf16*)(F.ws + WS_YO) + 512, lds);
        } else { const int c = u - 1024, b = c >> 3, h = c & 7;
            attn_body::attn_unit<8>((long)b * TP, h, (long)b * TP, TCX / 64, Q, K, V, (attn_body::bf16*)(F.ws + WS_YO) + 512, lds); }
    }
}

constexpr int PH_PRO = 0, PH_PER_LAYER = 15, PH_FINAL = 1 + NLAYER * PH_PER_LAYER, NPH = PH_FINAL + 1;
enum { O_NORM1 = 0, O_INPROJ, O_PREPA, O_LORA, O_SCAN, O_ATTN, O_POST, O_MG1A, O_MG1B, O_MG2, O_NORM2, O_TOPK, O_GATHER, O_MUP, O_MDOWN };
__device__ __forceinline__ void ph_inproj(int l) { KA A = kargs(); const Frame F = mk_frame(A);
    pg8::Gemm g{(const bf16*)(F.ws + WS_H), (const bf16*)(F.ws + WS_WIN) + (size_t)l * UC * DM, MR, UC, DM, DM, DM}; pg8::StaticOrder S; S.init(MR, UC, F.G, lbid(), 0, DM);
    pg8::EpiStore E{(bf16*)(F.ws + WS_U), UC}; pg8::gemm_phase<pg8::EpiStore, pg8::StaticOrder, true, true>(F.lds + RING_OFF, g, S, E); }
__device__ __forceinline__ void ph_lora(int l) { KA A = kargs(); const Frame F = mk_frame(A);
    pg8::Gemm g{(const bf16*)(F.ws + WS_L), (const bf16*)(F.ws + WS_WLORA) + (size_t)l * LOC * LK, MR, LOC, LK, LK, LK}; pg8::LoraOrder S; S.init(MR, LOC, F.G, lbid(), 0, LK);
    pg8::EpiLora E{(bf16*)(F.ws + WS_LO), LOC, A->in[I_DW0] + l * 1024, A->in[I_A0] + l * 1024}; pg8::gemm_phase<pg8::EpiLora, pg8::LoraOrder, true, true>(F.lds + RING_OFF, g, S, E); }
__device__ __forceinline__ void ph_mg1(int l) { KA A = kargs(); const Frame F = mk_frame(A);
    pg8::Gemm g{(const bf16*)(F.ws + WS_YO), (const bf16*)(F.ws + WS_WBR) + (size_t)l * DM * DM, MR, DM, DM, DM, DM}; pg8::MergeOrder S; S.init(MR, DM, F.G, lbid(), l == NLAYER - 1, DM);
    pg8::EpiMergeK E{(const bf16*)(F.ws + WS_U) + U_GR, (const bf16*)(F.ws + WS_U) + U_GA, UC, (bf16*)(F.ws + WS_M1)}; pg8::gemm_phase<pg8::EpiMergeK, pg8::MergeOrder, true, true>(F.lds + RING_OFF, g, S, E); }
__device__ __forceinline__ void ph_mg2(int l) { KA A = kargs(); const Frame F = mk_frame(A);
    pg8::Gemm g{(const bf16*)(F.ws + WS_M1), (const bf16*)(F.ws + WS_WOUT) + (size_t)l * DM * DM, MR, DM, DM, DM, DM}; pg8::StaticOrder S; S.init(MR, DM, F.G, lbid(), l == NLAYER - 1, DM);
    pg8::EpiResid E{(float*)(F.ws + WS_X), (const float*)(F.ws + WS_MODV) + (size_t)l * 5 * 6144}; pg8::gemm_phase<pg8::EpiResid, pg8::StaticOrder, true, true>(F.lds + RING_OFF, g, S, E); }
__device__ __forceinline__ void ph_mup(int l) { KA A = kargs(); const Frame F = mk_frame(A); const int nM = (l == 0) ? SLOT_ALL / 256 : SLOT_L / 256;
    pg8::Gemm g{(const bf16*)(F.ws + WS_H), (const bf16*)(F.ws + WS_WGU), nM * 256, 2 * FF, DM, DM, DM}; pg8::MoeOrderT<true> S; S.idx = (const int*)(F.ws + WS_IDX); S.init(nM, 2 * FF / 256, F.G, lbid(), DM);
    pg8::EpiMoeUp E{(bf16*)(F.ws + WS_HID), FF}; pg8::gemm_phase<pg8::EpiMoeUp, pg8::MoeOrderT<true>, true, true>(F.lds + RING_OFF, g, S, E); }
__device__ __forceinline__ void ph_mdown(int l) { KA A = kargs(); const Frame F = mk_frame(A); const int nM = (l == 0) ? SLOT_ALL / 256 : SLOT_L / 256;
    pg8::Gemm g{(const bf16*)(F.ws + WS_HID), (const bf16*)(F.ws + WS_WD), nM * 256, DM, FF, FF, FF}; pg8::MoeOrderT<false> S; S.idx = nullptr; S.init(nM, DM / 256, F.G, lbid(), FF);
    pg8::EpiMoeDown E{(bf16*)(F.ws + WS_XE), (const float*)(F.ws + WS_GATEV)}; pg8::gemm_phase<pg8::EpiMoeDown, pg8::MoeOrderT<false>, true, true>(F.lds + RING_OFF, g, S, E); }

__global__ void __launch_bounds__(NWAVES * 64, 2) fwd(Args args) {
    extern __shared__ __attribute__((aligned(16))) unsigned char lds[];
    {   LAS unsigned char* l3 = (LAS unsigned char*)lds;
        for (int u = threadIdx.x; u < (LDS_BYTES - LDSCTL_OFF) / 4; u += NWAVES * 64) ((LAS unsigned*)(l3 + LDSCTL_OFF))[u] = 0u; }
    __syncthreads();
    const int lo = args.ph_lo, hi = args.ph_hi, use_bar = args.use_bar;
    XcdBarrier bar; bar.bar = (unsigned*)(args.ws + WS_CTL) + CW_BAR; bar.x = 0; bar.st = nullptr;
    if (use_bar) bar = xcd_barrier_post((unsigned*)(args.ws + WS_CTL) + CW_BAR, (volatile LAS unsigned*)((LAS unsigned char*)lds + MISC_OFF) + 8);
#define IN(k) (lo <= (k) && (k) < hi)
#define SEAM(k) do { if (IN(k) && IN((k) + 1) && use_bar) xcd_barrier(bar); STAMP(k); } while (0)
#define STAMP(k) do { if (PROBE_MASK != 0ull && blockIdx.x == 0 && threadIdx.x == 0) { volatile LAS unsigned long long* pw = (volatile LAS unsigned long long*)((LAS unsigned char*)lds + MISC_OFF + 64); \
        const unsigned long long now = __builtin_amdgcn_s_memrealtime(); if ((PROBE_MASK >> (k)) & 1ull) pw[1] += now - pw[0]; pw[0] = now; } } while (0)
    if (PROBE_MASK != 0ull && blockIdx.x == 0 && threadIdx.x == 0) { volatile LAS unsigned long long* pw = (volatile LAS unsigned long long*)((LAS unsigned char*)lds + MISC_OFF + 64); pw[0] = __builtin_amdgcn_s_memrealtime(); pw[1] = 0ull; }
    if (IN(PH_PRO)) { p_prologue(); }
    SEAM(PH_PRO);
#pragma unroll 1
    for (int l = 0; l < NLAYER; ++l) {
        const int pb = 1 + l * PH_PER_LAYER;
        if (IN(pb + O_NORM1)) { if (l == 0) p_rownorm<0>(); else {
            const int wv = __builtin_amdgcn_readfirstlane(ltid() >> 6);
#pragma unroll 1
            for (int step = 0; step < 2; ++step) { if ((step ^ wv) & 1) { KA A = kargs(); const Frame F = mk_frame(A); cvt_moe(F, A, 1); } else p_rownorm<1>(); } } }
        SEAM(pb + O_NORM1);
        if (IN(pb + O_INPROJ)) ph_inproj(l);
        SEAM(pb + O_INPROJ);
        if (IN(pb + O_PREPA)) p_prep_a(l);
        SEAM(pb + O_PREPA);
        if (IN(pb + O_LORA)) ph_lora(l);
        SEAM(pb + O_LORA);
#ifdef SCAN_XMODE
        if (IN(pb + O_SCAN)) p_scan<SCAN_XMODE>(l);
#endif
        if (IN(pb + O_SCAN)) p_scan<0>(l);
        STAMP(pb + O_SCAN);
        if (IN(pb + O_ATTN)) p_attn((char*)lds + RING_OFF, l);
        SEAM(pb + O_ATTN);
        if (IN(pb + O_POST)) p_post(l);
        SEAM(pb + O_POST);
        if (IN(pb + O_MG1A)) ph_mg1(l);
        STAMP(pb + O_MG1A);
        SEAM(pb + O_MG1B);
        if (IN(pb + O_MG2)) ph_mg2(l);
        SEAM(pb + O_MG2);
        if (IN(pb + O_NORM2)) p_norm2(l);
        SEAM(pb + O_NORM2);
        if (IN(pb + O_TOPK)) p_topk(l);
        SEAM(pb + O_TOPK);
        STAMP(pb + O_GATHER);
        if (IN(pb + O_MUP)) ph_mup(l);
        SEAM(pb + O_MUP);
        if (IN(pb + O_MDOWN)) ph_mdown(l);
        SEAM(pb + O_MDOWN);
    }
    if (IN(PH_FINAL)) { p_rownorm<2>(); }
    STAMP(PH_FINAL);
    if (PROBE_MASK != 0ull && blockIdx.x == 0 && threadIdx.x == 0) { volatile LAS unsigned long long* pw = (volatile LAS unsigned long long*)((LAS unsigned char*)lds + MISC_OFF + 64);
        const unsigned long long t0 = pw[0], d = pw[1]; while (__builtin_amdgcn_s_memrealtime() - t0 < d) __builtin_amdgcn_s_sleep(8); }
#undef IN
#undef SEAM
#undef STAMP
}

extern "C" void kernel_launch(void* const* d_in, const int* in_sizes, int n_in, void* d_out, int out_size, void* d_ws, size_t ws_size, hipStream_t stream) {
    static int grid = 0;
    if (grid == 0) {
        if (n_in != 30 || out_size != NB * TL * DM || ws_size < WS_END) { fprintf(stderr, "kernel_launch: unexpected problem (n_in %d, out %d, ws %zu < %zu)\n", n_in, out_size, ws_size, (size_t)WS_END); grid = -1; return; }
        int dev = 0, cus = 0, per_cu = 0;
        if (hipGetDevice(&dev) != hipSuccess || hipDeviceGetAttribute(&cus, hipDeviceAttributeMultiprocessorCount, dev) != hipSuccess) { grid = -1; return; }
        if (hipFuncSetAttribute((const void*)fwd, hipFuncAttributeMaxDynamicSharedMemorySize, LDS_BYTES) != hipSuccess) { fprintf(stderr, "kernel_launch: hipFuncSetAttribute failed\n"); grid = -1; return; }
        if (hipOccupancyMaxActiveBlocksPerMultiprocessor(&per_cu, (const void*)fwd, NWAVES * 64, LDS_BYTES) != hipSuccess || per_cu < 1) fprintf(stderr, "kernel_launch: occupancy query reports %d\n", per_cu);
        (void)hipGetLastError();
        grid = cus;
    }
    if (grid < 0) return;
    if (hipMemsetAsync((char*)d_ws + WS_CTL, 0, CTL_ZERO_BYTES, stream) != hipSuccess) return;
    Args a{};
    for (int i = 0; i < 30; ++i) a.in[i] = (const float*)d_in[i];
    a.out = (float*)d_out; a.ws = (unsigned char*)d_ws; a.pad = 0;
#if MK_PER_PHASE
    for (int ph = 0; ph < NPH; ++ph) { a.ph_lo = ph; a.ph_hi = ph + 1; a.use_bar = 0;
        hipLaunchKernelGGL(fwd, dim3(grid), dim3(NWAVES * 64), LDS_BYTES, stream, a); }
#else
    a.ph_lo = 0; a.ph_hi = NPH; a.use_bar = 1;
    hipLaunchKernelGGL(fwd, dim3(grid), dim3(NWAVES * 64), LDS_BYTES, stream, a);
#endif
}
```
